# Optimizing an MI355X kernel written in HIP

```python
import jax, jax.numpy as jnp
from jax import lax
import numpy as np

D_MODEL = 1024
BATCH = 2
SEQ = 8192
DEPTH = 1

D_MIX = D_MODEL
GDN_HEADS = 4
GDN_DK = 128
GDN_DV = 128
GDN_QK = GDN_HEADS * GDN_DK
GDN_V = GDN_HEADS * GDN_DV
GDN_CONV = 4
GDN_CHUNK = 64
CF_CH = D_MIX - GDN_V
CF_KERNEL = 31
N_EXPERTS = 32
TOP_K = 4
D_FF = D_MODEL
SWIGLU_LIMIT = 7.0
SWIGLU_ALPHA = 1.702
MOE_BLOCK = 128
NORM_EPS = 1e-6

OFF_Q = 0
OFF_K = OFF_Q + GDN_QK
OFF_V = OFF_K + GDN_QK
OFF_Z = OFF_V + GDN_V
OFF_B = OFF_Z + GDN_V
OFF_A = OFF_B + GDN_HEADS
OFF_CF = OFF_A + GDN_HEADS
IN_COLS = OFF_CF + 2 * CF_CH

kernel_name = "hybrid_gdn_conformer_moe_block"


def _rmsnorm(x, w):
    xf = x.astype(jnp.float32)
    y = xf * lax.rsqrt(jnp.mean(xf * xf, axis=-1, keepdims=True) + NORM_EPS)
    return (y * w.astype(jnp.float32)).astype(x.dtype)


def _layernorm(x, w, b):
    xf = x.astype(jnp.float32)
    mu = jnp.mean(xf, axis=-1, keepdims=True)
    xc = xf - mu
    y = xc * lax.rsqrt(jnp.mean(xc * xc, axis=-1, keepdims=True) + NORM_EPS)
    return (y * w.astype(jnp.float32) + b.astype(jnp.float32)).astype(x.dtype)


def _gated_rmsnorm(o, w, z):
    of = o.astype(jnp.float32)
    y = of * lax.rsqrt(jnp.mean(of * of, axis=-1, keepdims=True) + NORM_EPS) * w.astype(jnp.float32)
    return (y * jax.nn.silu(z.astype(jnp.float32))).astype(z.dtype)


def _l2norm(t):
    return t * lax.rsqrt(jnp.sum(t * t, axis=-1, keepdims=True) + NORM_EPS)


def _causal_dwconv(x, w):
    width, ch = w.shape
    return lax.conv_general_dilated(
        x, w[:, None, :].astype(x.dtype), window_strides=(1,), padding=[(width - 1, 0)],
        dimension_numbers=("NWC", "WIO", "NWC"), feature_group_count=ch)


def _chunked_gated_delta_rule(q, k, v, g, beta):
    f32 = jnp.float32
    b, s, h, dk = q.shape
    dv = v.shape[-1]
    c = GDN_CHUNK
    n = s // c
    q = q.astype(f32) * (dk ** -0.5)
    k, v, g, beta = k.astype(f32), v.astype(f32), g.astype(f32), beta.astype(f32)

    def chunks(t):
        return t.reshape(b, n, c, h, -1).transpose(0, 3, 1, 2, 4)

    q, k, v = chunks(q), chunks(k), chunks(v)
    g = g.reshape(b, n, c, h).transpose(0, 3, 1, 2)
    beta = beta.reshape(b, n, c, h).transpose(0, 3, 1, 2)
    g = jnp.cumsum(g, axis=-1)

    causal = jnp.tril(jnp.ones((c, c), dtype=bool))
    strict = jnp.tril(jnp.ones((c, c), dtype=bool), k=-1)
    diff = g[..., :, None] - g[..., None, :]
    decay = jnp.exp(jnp.where(causal, diff, -jnp.inf))

    kb = k * beta[..., None]
    vb = v * beta[..., None]
    a_strict = jnp.where(strict, jnp.einsum("bhncd,bhnmd->bhncm", kb, k) * decay, 0.0)
    lower = jnp.eye(c, dtype=f32) + a_strict
    rhs = jnp.concatenate([vb, kb * jnp.exp(g)[..., None]], axis=-1)
    sol = lax.linalg.triangular_solve(lower, rhs, left_side=True, lower=True, unit_diagonal=True)
    u_val = sol[..., :dv]
    w_key = sol[..., dv:]

    intra = jnp.einsum("bhncd,bhnmd->bhncm", q, k) * decay
    q_dec = q * jnp.exp(g)[..., None]
    k_tail = k * jnp.exp(g[..., -1:] - g)[..., None]
    g_tot = jnp.exp(g[..., -1])

    xs = tuple(jnp.moveaxis(t, 2, 0) for t in (u_val, w_key, q_dec, k_tail, intra, g_tot))

    def step(state, inp):
        u_c, w_c, qd_c, kt_c, in_c, gt_c = inp
        v_new = u_c - jnp.einsum("bhcd,bhde->bhce", w_c, state)
        o_c = jnp.einsum("bhcd,bhde->bhce", qd_c, state) + jnp.einsum("bhcm,bhme->bhce", in_c, v_new)
        state = state * gt_c[..., None, None] + jnp.einsum("bhcd,bhce->bhde", kt_c, v_new)
        return state, o_c

    state0 = jnp.zeros((b, h, dk, dv), f32)
    _, o = lax.scan(step, state0, xs)
    return o.transpose(1, 0, 3, 2, 4).reshape(b, s, h, dv)


def _moe(xn, w_router, b_router, w_gate_up, b_gate_up, w_down, b_down):
    b, s, d = xn.shape
    t = b * s
    xt = xn.reshape(t, d)
    logits = (xt @ w_router + b_router).astype(jnp.float32)
    top_val, top_idx = lax.top_k(logits, TOP_K)
    gates = jax.nn.softmax(top_val, axis=-1)

    p = t * TOP_K
    e_flat = top_idx.reshape(p).astype(jnp.int32)
    tok_flat = jnp.arange(p, dtype=jnp.int32) // TOP_K
    g_flat = gates.reshape(p)
    order = jnp.argsort(e_flat)
    e_s, tok_s, g_s = e_flat[order], tok_flat[order], g_flat[order]

    counts = jnp.bincount(e_s, length=N_EXPERTS).astype(jnp.int32)
    padded = ((counts + MOE_BLOCK - 1) // MOE_BLOCK) * MOE_BLOCK
    start = jnp.cumsum(counts) - counts
    pend = jnp.cumsum(padded)
    pstart = pend - padded
    dest = pstart[e_s] + (jnp.arange(p, dtype=jnp.int32) - start[e_s])

    n_blocks = -(-p // MOE_BLOCK) + N_EXPERTS
    rows = n_blocks * MOE_BLOCK
    row_tok = jnp.full((rows,), t, jnp.int32).at[dest].set(tok_s)
    row_gate = jnp.zeros((rows,), jnp.float32).at[dest].set(g_s)
    blk_start = jnp.arange(n_blocks, dtype=jnp.int32) * MOE_BLOCK
    blk_exp = jnp.minimum(jnp.searchsorted(pend, blk_start, side="right"), N_EXPERTS - 1)

    x_pad = jnp.concatenate([xt, jnp.zeros((1, d), xt.dtype)], axis=0)
    xb = x_pad[row_tok].reshape(n_blocks, MOE_BLOCK, d)

    def expert_block(args):
        x_blk, e = args
        hid = x_blk @ w_gate_up[e] + b_gate_up[e]
        gate, up = hid[:, :D_FF], hid[:, D_FF:]
        gate = jnp.minimum(gate, SWIGLU_LIMIT)
        up = jnp.clip(up, -SWIGLU_LIMIT, SWIGLU_LIMIT)
        glu = gate * jax.nn.sigmoid(SWIGLU_ALPHA * gate)
        return ((up + 1.0) * glu) @ w_down[e] + b_down[e]

    yb = lax.map(expert_block, (xb, blk_exp))
    weighted = yb.reshape(rows, d).astype(jnp.float32) * row_gate[:, None]
    y = jax.ops.segment_sum(weighted, row_tok, num_segments=t + 1)[:t]
    return y.astype(xn.dtype).reshape(b, s, d)


def setup_inputs(seed: int = 0) -> dict:
    key = jax.random.key(seed)
    ks = jax.random.split(key, 20)
    f32 = jnp.float32
    nrm = lambda k, shape, sc: jax.random.normal(k, shape, f32) * sc
    return {
        "x": jax.random.normal(ks[0], (BATCH, SEQ, D_MODEL), f32),
        "attn_norm_w": 1.0 + nrm(ks[1], (DEPTH, D_MODEL), 0.02),
        "w_in": nrm(ks[2], (DEPTH, D_MODEL, IN_COLS), D_MODEL ** -0.5),
        "gdn_conv_w": nrm(ks[3], (DEPTH, GDN_CONV, 2 * GDN_QK + GDN_V), GDN_CONV ** -0.5),
        "gdn_a_log": jnp.log(jax.random.uniform(ks[4], (DEPTH, GDN_HEADS), f32, 1.0, 16.0)),
        "gdn_dt_bias": nrm(ks[5], (DEPTH, GDN_HEADS), 0.1),
        "gdn_norm_w": 1.0 + nrm(ks[6], (DEPTH, GDN_DV), 0.02),
        "cf_dw_w": nrm(ks[7], (DEPTH, CF_KERNEL, CF_CH), CF_KERNEL ** -0.5),
        "cf_dw_b": nrm(ks[8], (DEPTH, CF_CH), 0.02),
        "cf_ln_w": 1.0 + nrm(ks[9], (DEPTH, CF_CH), 0.02),
        "cf_ln_b": nrm(ks[10], (DEPTH, CF_CH), 0.02),
        "w_out": nrm(ks[11], (DEPTH, D_MIX, D_MODEL), D_MIX ** -0.5),
        "ffn_norm_w": 1.0 + nrm(ks[12], (DEPTH, D_MODEL), 0.02),
        "w_router": nrm(ks[13], (DEPTH, D_MODEL, N_EXPERTS), D_MODEL ** -0.5),
        "b_router": nrm(ks[14], (DEPTH, N_EXPERTS), 0.01),
        "w_gate_up": nrm(ks[15], (DEPTH, N_EXPERTS, D_MODEL, 2 * D_FF), D_MODEL ** -0.5),
        "b_gate_up": nrm(ks[16], (DEPTH, N_EXPERTS, 2 * D_FF), 0.02),
        "w_down": nrm(ks[17], (DEPTH, N_EXPERTS, D_FF, D_MODEL), D_FF ** -0.5),
        "b_down": nrm(ks[18], (DEPTH, N_EXPERTS, D_MODEL), 0.02),
        "final_norm_w": 1.0 + nrm(ks[19], (D_MODEL,), 0.02),
    }


def reference(x, attn_norm_w, w_in, gdn_conv_w, gdn_a_log, gdn_dt_bias, gdn_norm_w,
              cf_dw_w, cf_dw_b, cf_ln_w, cf_ln_b, w_out, ffn_norm_w, w_router, b_router,
              w_gate_up, b_gate_up, w_down, b_down, final_norm_w):
    b, s, _ = x.shape
    for l in range(DEPTH):
        h = _rmsnorm(x, attn_norm_w[l])
        proj = h @ w_in[l]

        qkv = jax.nn.silu(_causal_dwconv(proj[..., OFF_Q:OFF_Z], gdn_conv_w[l]))
        q = _l2norm(qkv[..., :GDN_QK].astype(jnp.float32).reshape(b, s, GDN_HEADS, GDN_DK))
        k = _l2norm(qkv[..., GDN_QK:2 * GDN_QK].astype(jnp.float32).reshape(b, s, GDN_HEADS, GDN_DK))
        v = qkv[..., 2 * GDN_QK:].reshape(b, s, GDN_HEADS, GDN_DV)
        z = proj[..., OFF_Z:OFF_B].reshape(b, s, GDN_HEADS, GDN_DV)
        beta = jax.nn.sigmoid(proj[..., OFF_B:OFF_A].astype(jnp.float32))
        g = -jnp.exp(gdn_a_log[l].astype(jnp.float32)) * jax.nn.softplus(
            proj[..., OFF_A:OFF_CF].astype(jnp.float32) + gdn_dt_bias[l].astype(jnp.float32))
        o = _chunked_gated_delta_rule(q, k, v, g, beta)
        out_a = _gated_rmsnorm(o, gdn_norm_w[l], z).reshape(b, s, GDN_V)

        cf = proj[..., OFF_CF:]
        u = cf[..., :CF_CH] * jax.nn.sigmoid(cf[..., CF_CH:])
        u = _causal_dwconv(u, cf_dw_w[l]) + cf_dw_b[l]
        u = jax.nn.silu(_layernorm(u, cf_ln_w[l], cf_ln_b[l]))

        mix = jnp.concatenate([out_a.astype(x.dtype), u.astype(x.dtype)], axis=-1)
        x = x + mix @ w_out[l]

        x = x + _moe(_rmsnorm(x, ffn_norm_w[l]), w_router[l], b_router[l],
                     w_gate_up[l], b_gate_up[l], w_down[l], b_down[l])
    return _rmsnorm(x, final_norm_w)
```

```cpp
#include <hip/hip_runtime.h>
#include <cstdint>
#include <cstdio>
#include <type_traits>

namespace cfg {
constexpr int B = 2, S = 8192, T = B * S, D = 1024;
constexpr int H = 4, DK = 128, DV = 128, QK = 512;
constexpr int CF = 512, CFK = 31, NE = 32, TOPK = 4, FF = 1024;
constexpr int OFF_B = 2048, OFF_A = 2052, OFF_CF = 2056, IN_COLS = 3080;
constexpr int PC = 3072;
constexpr float EPS = 1e-6f;
constexpr int RB = 256;
constexpr int MAXBLK = 256 + 32;
constexpr int RPAD = MAXBLK * RB;
constexpr int NWG = 256;
}
using namespace cfg;

typedef unsigned short bf16;
__device__ __forceinline__ unsigned f2bf(float f) { unsigned u = __builtin_bit_cast(unsigned, f); return (u + 0x7fffu + ((u >> 16) & 1u)) >> 16; }
__device__ __forceinline__ float bf2f(unsigned h) { return __builtin_bit_cast(float, h << 16); }
__device__ __forceinline__ unsigned pk2(float lo, float hi) { return f2bf(lo) | (f2bf(hi) << 16); }
__device__ __forceinline__ float sigmoidf_(float x) { return __builtin_amdgcn_rcpf(1.f + __expf(-x)); }
__device__ __forceinline__ float siluf_(float x) { return x * sigmoidf_(x); }
__device__ __forceinline__ float softplusf_(float x) { return fmaxf(x, 0.f) + log1pf(__expf(-fabsf(x))); }
__device__ __forceinline__ float wave_sum(float v) {
    v += __builtin_bit_cast(float, __builtin_amdgcn_update_dpp(0, __builtin_bit_cast(int, v), 0x111, 0xf, 0xf, false));
    v += __builtin_bit_cast(float, __builtin_amdgcn_update_dpp(0, __builtin_bit_cast(int, v), 0x112, 0xf, 0xf, false));
    v += __builtin_bit_cast(float, __builtin_amdgcn_update_dpp(0, __builtin_bit_cast(int, v), 0x114, 0xf, 0xf, false));
    v += __builtin_bit_cast(float, __builtin_amdgcn_update_dpp(0, __builtin_bit_cast(int, v), 0x118, 0xf, 0xf, false));
    v += __builtin_bit_cast(float, __builtin_amdgcn_update_dpp(0, __builtin_bit_cast(int, v), 0x142, 0xa, 0xf, false));
    v += __builtin_bit_cast(float, __builtin_amdgcn_update_dpp(0, __builtin_bit_cast(int, v), 0x143, 0xc, 0xf, false));
    return __builtin_bit_cast(float, __builtin_amdgcn_readlane(__builtin_bit_cast(int, v), 63));
}

constexpr size_t MiB = 1u << 20;
constexpr size_t WS_CTL = 0;
constexpr size_t WS_HN = 1 * MiB;
constexpr size_t WS_PROJ = WS_HN + 32 * MiB;
constexpr size_t WS_BETA = WS_PROJ + 96 * MiB;
constexpr size_t WS_G = WS_BETA + 1 * MiB;
constexpr size_t WS_MIX = WS_G + 1 * MiB;
constexpr size_t WS_XMID = WS_MIX + 32 * MiB;
constexpr size_t WS_TOPE = WS_XMID + 64 * MiB;
constexpr size_t WS_TOPG = WS_TOPE + 1 * MiB;
constexpr size_t WS_POS = WS_TOPG + 1 * MiB;
constexpr size_t WS_HIST = WS_POS + 1 * MiB;
constexpr size_t WS_BLKE = WS_HIST + 1 * MiB;
constexpr size_t WS_RGATE = WS_BLKE + 1 * MiB;
constexpr size_t WS_XG = WS_RGATE + 1 * MiB;
constexpr size_t WS_HB = WS_XG + 144 * MiB;
constexpr size_t WS_Y = WS_HB + 144 * MiB;
constexpr size_t WS_WINT = WS_Y + 144 * MiB;
constexpr size_t WS_WOUTT = WS_WINT + 6 * MiB;
constexpr size_t WS_WGUT = WS_WOUTT + 2 * MiB;
constexpr size_t WS_WDT = WS_WGUT + 128 * MiB;
constexpr size_t WS_END = WS_WDT + 64 * MiB;


#define GAS __attribute__((address_space(1)))
#define LAS __attribute__((address_space(3)))
typedef unsigned v4u __attribute__((ext_vector_type(4)));
#define LDS_WAIT() asm volatile("s_waitcnt lgkmcnt(0)" ::: "memory")
#define VM_WAIT() asm volatile("s_waitcnt vmcnt(0)" ::: "memory")

namespace pg8 {
#define PG8_LAS __attribute__((address_space(3)))
typedef unsigned short bf16_t;
typedef short bf16x8 __attribute__((ext_vector_type(8)));
typedef float f32x4 __attribute__((ext_vector_type(4)));
typedef unsigned u32x4 __attribute__((ext_vector_type(4)));
constexpr int BM = 256, BK = 64, HALF = 128, HTB = HALF * BK * 2  , STAGE_BYTES = 8 * HTB, NXCD = 8, WGM = 8;

__host__ __device__ __forceinline__ int lds_byte(int r, int c) { const int st = (r >> 4) * 2 + (c >> 5), rr = r & 15, cc = c & 31, ob = rr * 64 + cc * 2; return st * 1024 + (ob ^ (((ob >> 9) & 1) << 5)); }
__host__ __device__ __forceinline__ void stage_rc(int b, int& R, int& C) { const int st = b / 1024, sb = b % 1024, swz = sb ^ (((sb >> 9) & 1) << 5); R = (st >> 1) * 16 + swz / 64; C = (st & 1) * 32 + (swz % 64) / 2; }
__host__ __device__ __forceinline__ int perm32(int rho) { const int n = rho >> 4, i = rho & 15; return 8 * (i >> 2) + 4 * n + (i & 3); }

struct Unit { int pm, pn, pb, e; };
struct Gemm { const bf16_t* A; const bf16_t* Bt; int M, N, K; };

struct StaticOrder {
    int nM, nN, nwg, G, c;
    __host__ __device__ void init(int M, int N, int G_, int c_) { nM = M / BM; nN = N / BM; nwg = nM * nN; G = G_; c = c_; }
    __host__ __device__ bool next(int i, Unit& u) const {
        const long L = (long)i * G + c; if (L >= nwg) return false;
        int wgid = (int)L; { const int q = nwg / NXCD, r = nwg % NXCD, xcd = wgid % NXCD, off = wgid / NXCD; wgid = (xcd < r ? xcd * (q + 1) : r * (q + 1) + (xcd - r) * q) + off; }
        const int nig = WGM * nN, gid = wgid / nig, fm = gid * WGM, gsz = (nM - fm) < WGM ? (nM - fm) : WGM;
        u.pm = fm + ((wgid % nig) % gsz); u.pn = (wgid % nig) / gsz; u.pb = u.pn; u.e = 0; return true;
    }
    __device__ __forceinline__ void a_ready(const Unit&) const {}
    __device__ __forceinline__ void done(const Unit&) const {}
};

__device__ __forceinline__ unsigned cvt_pk_bf16(float lo, float hi) { unsigned r; asm volatile("v_cvt_pk_bf16_f32 %0, %1, %2" : "=v"(r) : "v"(lo), "v"(hi)); return r; }
__device__ __forceinline__ int ld_i32_sc1(const int* p) { return (int)__hip_atomic_load((const unsigned*)p, __ATOMIC_RELAXED, __HIP_MEMORY_SCOPE_AGENT); }
struct MoeOrder {
    int nM, nN, nwg, G, c; const int* blke;
    __device__ void init(const int* blke_, int nblk_slot, int nN_, int G_, int c_) { blke = blke_; nM = ld_i32_sc1(blke_ + nblk_slot); nN = nN_; nwg = nM * nN; G = G_; c = c_; }
    __device__ bool next(int i, Unit& u) const {
        const long L = (long)i * G + c; if (L >= nwg) return false;
        int wgid = (int)L; { const int q = nwg / NXCD, r = nwg % NXCD, xcd = wgid % NXCD, off = wgid / NXCD; wgid = (xcd < r ? xcd * (q + 1) : r * (q + 1) + (xcd - r) * q) + off; }
        const int nig = WGM * nN, gid = wgid / nig, fm = gid * WGM, gsz = (nM - fm) < WGM ? (nM - fm) : WGM;
        u.pm = fm + ((wgid % nig) % gsz); u.pn = (wgid % nig) / gsz; u.e = ld_i32_sc1(blke + u.pm); u.pb = u.e * nN + u.pn; return true;
    }
    __device__ __forceinline__ void a_ready(const Unit&) const {}
    __device__ __forceinline__ void done(const Unit&) const {}
};
struct EpiResBf16 {
    static constexpr bool PERM = true, AFTER_DRAIN = false;
    bf16_t* O; const float* R; int ldc;
    __device__ __forceinline__ void operator()(const f32x4 (&acc)[2][2][4][2], const Unit& u, int wr, int wc, int fr, int fq) const {
        const int row0 = u.pm * BM + wr * 64 + fr, col0 = u.pn * BM + wc * 32 + 8 * fq;
#pragma unroll
        for (int ai = 0; ai < 2; ++ai)
#pragma unroll
            for (int m = 0; m < 4; ++m) { const size_t ro = (size_t)(row0 + ai * HALF + m * 16) * ldc + col0;
#pragma unroll
                for (int bj = 0; bj < 2; ++bj) { const f32x4 v0 = acc[ai][bj][m][0] + *(const f32x4*)(R + ro + bj * HALF), v1 = acc[ai][bj][m][1] + *(const f32x4*)(R + ro + bj * HALF + 4);
                    u32x4 w; w.x = cvt_pk_bf16(v0[0], v0[1]); w.y = cvt_pk_bf16(v0[2], v0[3]); w.z = cvt_pk_bf16(v1[0], v1[1]); w.w = cvt_pk_bf16(v1[2], v1[3]);
                    *(u32x4*)(O + ro + bj * HALF) = w; } }
    }
};
struct EpiSwiglu {
    static constexpr bool PERM = true, AFTER_DRAIN = false;
    unsigned char* O; const float* bgu;
    __device__ __forceinline__ void operator()(const f32x4 (&acc)[2][2][4][2], const Unit& u, int wr, int wc, int fr, int fq) const {
        const int row0 = u.pm * BM + wr * 64 + fr, colg = u.pn * HALF + wc * 32 + 8 * fq;
        const float* bg = bgu + (size_t)u.e * 2048 + colg;
        const f32x4 bgv[2] = {*(const f32x4*)bg, *(const f32x4*)(bg + 4)}, buv[2] = {*(const f32x4*)(bg + 1024), *(const f32x4*)(bg + 1028)};
#pragma unroll
        for (int ai = 0; ai < 2; ++ai)
#pragma unroll
            for (int m = 0; m < 4; ++m) { unsigned char* rowp = O + (size_t)(row0 + ai * HALF + m * 16) * 1024 + colg;
                float r[8];
#pragma unroll
                for (int n = 0; n < 2; ++n) { const f32x4 g = acc[ai][0][m][n] + bgv[n], uu = acc[ai][1][m][n] + buv[n];
#pragma unroll
                    for (int i = 0; i < 4; ++i) { const float gc = fminf(g[i], 7.f), uc = fminf(fmaxf(uu[i], -7.f), 7.f);
                        r[4 * n + i] = 4.f * (uc + 1.f) * gc * __builtin_amdgcn_rcpf(1.f + __expf(-1.702f * gc)); } }
                int w0 = 0, w1 = 0;
                w0 = __builtin_amdgcn_cvt_pk_fp8_f32(r[0], r[1], w0, false); w0 = __builtin_amdgcn_cvt_pk_fp8_f32(r[2], r[3], w0, true);
                w1 = __builtin_amdgcn_cvt_pk_fp8_f32(r[4], r[5], w1, false); w1 = __builtin_amdgcn_cvt_pk_fp8_f32(r[6], r[7], w1, true);
                typedef unsigned u32x2_ __attribute__((ext_vector_type(2)));
                *(u32x2_*)rowp = (u32x2_){(unsigned)w0, (unsigned)w1}; }
    }
};
struct EpiDown {
    static constexpr bool PERM = true, AFTER_DRAIN = false;
    bf16_t* O; const float* bd; const float* rgate;
    __device__ __forceinline__ void operator()(const f32x4 (&acc)[2][2][4][2], const Unit& u, int wr, int wc, int fr, int fq) const {
        const int row0 = u.pm * BM + wr * 64 + fr, col0 = u.pn * BM + wc * 32 + 8 * fq;
        const float* bp = bd + (size_t)u.e * 1024 + col0;
        f32x4 bv[2][2];
#pragma unroll
        for (int bj = 0; bj < 2; ++bj)
#pragma unroll
            for (int n = 0; n < 2; ++n) bv[bj][n] = *(const f32x4*)(bp + bj * HALF + 4 * n);
#pragma unroll
        for (int ai = 0; ai < 2; ++ai)
#pragma unroll
            for (int m = 0; m < 4; ++m) { const int row = row0 + ai * HALF + m * 16; const float sc = __hip_atomic_load(rgate + row, __ATOMIC_RELAXED, __HIP_MEMORY_SCOPE_AGENT);
                bf16_t* rowp = O + (size_t)row * 1024 + col0;
#pragma unroll
                for (int bj = 0; bj < 2; ++bj) { const f32x4 v0 = (acc[ai][bj][m][0] + bv[bj][0]) * sc, v1 = (acc[ai][bj][m][1] + bv[bj][1]) * sc;
                    u32x4 w; w.x = cvt_pk_bf16(v0[0], v0[1]); w.y = cvt_pk_bf16(v0[2], v0[3]); w.z = cvt_pk_bf16(v1[0], v1[1]); w.w = cvt_pk_bf16(v1[2], v1[3]);
                    *(u32x4*)(rowp + bj * HALF) = w; } }
    }
};
struct EpiPlainBf16 {
    static constexpr bool PERM = true, AFTER_DRAIN = false;
    bf16_t* O; int ldc;
    __device__ __forceinline__ void operator()(const f32x4 (&acc)[2][2][4][2], const Unit& u, int wr, int wc, int fr, int fq) const {
        const int row0 = u.pm * BM + wr * 64 + fr, col0 = u.pn * BM + wc * 32 + 8 * fq;
#pragma unroll
        for (int ai = 0; ai < 2; ++ai)
#pragma unroll
            for (int m = 0; m < 4; ++m) { bf16_t* rowp = O + (size_t)(row0 + ai * HALF + m * 16) * ldc + col0;
#pragma unroll
                for (int bj = 0; bj < 2; ++bj) { const f32x4 v0 = acc[ai][bj][m][0], v1 = acc[ai][bj][m][1];
                    u32x4 w; w.x = cvt_pk_bf16(v0[0], v0[1]); w.y = cvt_pk_bf16(v0[2], v0[3]); w.z = cvt_pk_bf16(v1[0], v1[1]); w.w = cvt_pk_bf16(v1[2], v1[3]);
                    *(u32x4*)(rowp + bj * HALF) = w; } }
    }
};
template <class Epi, class Sched, bool ALIGN_EPI = false, bool SP2 = false, int F8W = 0, int F8A = 0>
__device__ __forceinline__ void gemm_phase(PG8_LAS unsigned char* lds, const Gemm g, const Sched& S, const Epi& E) {
    const int tid = threadIdx.x, wid = __builtin_amdgcn_readfirstlane(tid >> 6), lane = tid & 63, wr = wid >> 2, wc = wid & 3, fr = lane & 15, fq = lane >> 4;
    const int K = g.K, nt = K / BK;
    unsigned voffA[2], voffB[2];
#pragma unroll
    for (int i = 0; i < 2; ++i) { int R, C; stage_rc(tid * 16 + i * 8192, R, C); const int Rb = Epi::PERM ? ((R & ~31) + perm32(R & 31)) : R;
        voffA[i] = (unsigned)(R * K + C) * 2u; voffB[i] = (unsigned)(Rb * K + C) * 2u; }
    const size_t kstep = (size_t)(BK * 2);
    const size_t hstep = (size_t)HALF * K * 2;
    const size_t tstep = 2 * hstep;
    const unsigned ldsw = (unsigned)wid * 1024u;
    const int aoff = lds_byte(wr * 64 + fr, fq * 8), boff = lds_byte(wc * 32 + fr, fq * 8);
#define PG8_SA(b, h) (((b) * 2 + (h)) * HTB)
#define PG8_SB(b, h) ((4 + (b) * 2 + (h)) * HTB)
#define PG8_STAGE(bufoff, gbase, voff) do { _Pragma("unroll") for (int _i = 0; _i < 2; ++_i) \
        __builtin_amdgcn_global_load_lds((const unsigned*)((const char*)(gbase) + (voff)[_i]), (PG8_LAS unsigned*)(lds + (bufoff) + ldsw + _i * 8192), 16, 0, 0); } while (0)
#define PG8_LD1(dst, addr) do { if constexpr (F8W != 0) { (dst).v = __builtin_shufflevector(*(const PG8_LAS i32x4_*)(addr), *(const PG8_LAS i32x4_*)((addr) + 1024), 0, 1, 2, 3, 4, 5, 6, 7); } \
        else { (dst).v[0] = *(const PG8_LAS bf16x8*)(addr); (dst).v[1] = *(const PG8_LAS bf16x8*)((addr) + 1024); } } while (0)
#define PG8_LDA(dst, b, h) do { _Pragma("unroll") for (int m = 0; m < 4; ++m) PG8_LD1(dst[m], lds + PG8_SA(b, h) + aoff + m * 2048); } while (0)
#define PG8_LDB(dst, b, h) do { _Pragma("unroll") for (int n = 0; n < 2; ++n) PG8_LD1(dst[n], lds + PG8_SB(b, h) + boff + n * 2048); } while (0)
#define PG8_MMA(ai, bj, At, Bt) do { __builtin_amdgcn_s_setprio(1); _Pragma("unroll") for (int m = 0; m < 4; ++m) _Pragma("unroll") for (int n = 0; n < 2; ++n) { \
        if constexpr (F8W != 0) { asm volatile("v_mfma_scale_f32_16x16x128_f8f6f4 %0, %1, %2, %0, %3, %4 op_sel_hi:[0,0,0]" : "+v"(acc[ai][bj][m][n]) : "v"(Bt[n].v), "v"(At[m].v), "v"(f8sw), "v"(f8sa)); } \
        else { _Pragma("unroll") for (int k = 0; k < 2; ++k) acc[ai][bj][m][n] = __builtin_amdgcn_mfma_f32_16x16x32_bf16(Bt[n].v[k], At[m].v[k], acc[ai][bj][m][n], 0, 0, 0); } } \
        __builtin_amdgcn_s_setprio(0); } while (0)
#define PG8_WAIT_V(n) asm volatile("s_waitcnt vmcnt(" #n ")" ::: "memory")
#define PG8_WAIT_L(n) asm volatile("s_waitcnt lgkmcnt(" #n ")" ::: "memory")
#define PG8_BAR __builtin_amdgcn_s_barrier()
#define PG8_SCHED __builtin_amdgcn_sched_barrier(0)
    Unit cur, nxt; int ui = 0;
    if (!S.next(0, cur)) return;
    f32x4 acc[2][2][4][2];
#pragma unroll
    for (int a = 0; a < 2; ++a)
#pragma unroll
        for (int b = 0; b < 2; ++b)
#pragma unroll
            for (int m = 0; m < 4; ++m)
#pragma unroll
                for (int n = 0; n < 2; ++n) acc[a][b][m][n] = (f32x4){0.f, 0.f, 0.f, 0.f};
    typedef int i32x4_ __attribute__((ext_vector_type(4))); typedef int i32x8_ __attribute__((ext_vector_type(8)));
    struct FragBf { bf16x8 v[2]; }; struct FragF8 { i32x8_ v; };
    typedef typename std::conditional<F8W != 0, FragF8, FragBf>::type Frag;
    Frag At[4], B0[2], B1[2];
    const int f8sw = F8W, f8sa = F8A;
    const char* cA = (const char*)g.A + (size_t)cur.pm * tstep; const char* cB = (const char*)g.Bt + (size_t)cur.pb * tstep;
    S.a_ready(cur);
    if constexpr (SP2) {
        PG8_STAGE(PG8_SB(0, 0), cB, voffB); PG8_STAGE(PG8_SB(0, 1), cB + hstep, voffB); PG8_STAGE(PG8_SA(0, 0), cA, voffA); PG8_STAGE(PG8_SA(0, 1), cA + hstep, voffA);
        if (wr == 1) PG8_BAR;
        PG8_WAIT_V(2); PG8_BAR;
        PG8_STAGE(PG8_SB(1, 0), cB + kstep, voffB); PG8_STAGE(PG8_SA(1, 0), cA + kstep, voffA); PG8_STAGE(PG8_SB(1, 1), cB + hstep + kstep, voffB);
        PG8_WAIT_V(6); PG8_BAR;
    } else {
        PG8_STAGE(PG8_SB(0, 0), cB, voffB); PG8_STAGE(PG8_SA(0, 0), cA, voffA); PG8_STAGE(PG8_SB(0, 1), cB + hstep, voffB); PG8_STAGE(PG8_SA(0, 1), cA + hstep, voffA);
        if (wr == 1) PG8_BAR;
        PG8_WAIT_V(4); PG8_BAR;
        PG8_STAGE(PG8_SB(1, 0), cB + kstep, voffB); PG8_STAGE(PG8_SA(1, 0), cA + kstep, voffA); PG8_STAGE(PG8_SB(1, 1), cB + hstep + kstep, voffB);
        PG8_WAIT_V(6); PG8_BAR;
    }
    for (;;) {
        const bool has_next = S.next(ui + 1, nxt);
        const char* nA = has_next ? (const char*)g.A + (size_t)nxt.pm * tstep : cA; const char* nB = has_next ? (const char*)g.Bt + (size_t)nxt.pb * tstep : cB;
        for (int t = 0; t < nt; t += 2) {
            const bool last = (t == nt - 2);
            const char* a1 = cA + (size_t)(t + 1) * kstep;
            const char* a2 = last ? nA : cA + (size_t)(t + 2) * kstep; const char* b2 = last ? nB : cB + (size_t)(t + 2) * kstep;
            const char* a3 = a2 + kstep; const char* b3 = b2 + kstep;
            if (last && has_next) S.a_ready(nxt);
            if constexpr (SP2) {
            PG8_LDB(B0, 0, 0); PG8_LDB(B1, 0, 1); PG8_SCHED; PG8_LDA(At, 0, 0); PG8_STAGE(PG8_SA(1, 1), a1 + hstep, voffA);
            PG8_WAIT_V(8); PG8_WAIT_L(0); PG8_BAR; PG8_MMA(0, 0, At, B0); PG8_MMA(0, 1, At, B1); PG8_BAR; PG8_SCHED;
            PG8_LDA(At, 0, 1); PG8_STAGE(PG8_SB(0, 0), b2, voffB); PG8_STAGE(PG8_SB(0, 1), b2 + hstep, voffB); PG8_STAGE(PG8_SA(0, 0), a2, voffA);
            PG8_WAIT_V(8); PG8_WAIT_L(0); PG8_BAR; PG8_MMA(1, 0, At, B0); PG8_MMA(1, 1, At, B1); PG8_BAR; PG8_SCHED;
            PG8_LDB(B0, 1, 0); PG8_LDB(B1, 1, 1); PG8_SCHED; PG8_LDA(At, 1, 0); PG8_STAGE(PG8_SA(0, 1), a2 + hstep, voffA);
            PG8_WAIT_V(8); PG8_WAIT_L(0); PG8_BAR; PG8_MMA(0, 0, At, B0); PG8_MMA(0, 1, At, B1); PG8_BAR; PG8_SCHED;
            PG8_LDA(At, 1, 1); PG8_STAGE(PG8_SB(1, 0), b3, voffB); PG8_STAGE(PG8_SB(1, 1), b3 + hstep, voffB); PG8_STAGE(PG8_SA(1, 0), a3, voffA);
            PG8_WAIT_V(8); PG8_WAIT_L(0); PG8_BAR; PG8_MMA(1, 0, At, B0); PG8_MMA(1, 1, At, B1); PG8_BAR; PG8_SCHED;
            } else {
            PG8_LDB(B0, 0, 0); PG8_SCHED; PG8_LDA(At, 0, 0); PG8_STAGE(PG8_SA(1, 1), a1 + hstep, voffA);
            PG8_WAIT_L(8); PG8_BAR; PG8_WAIT_L(0); PG8_MMA(0, 0, At, B0); PG8_BAR; PG8_SCHED;
            PG8_LDB(B1, 0, 1); PG8_STAGE(PG8_SB(0, 0), b2, voffB);
            PG8_BAR; PG8_WAIT_L(0); PG8_MMA(0, 1, At, B1); PG8_BAR;
            PG8_LDA(At, 0, 1); PG8_STAGE(PG8_SA(0, 0), a2, voffA);
            PG8_BAR; PG8_WAIT_L(0); PG8_MMA(1, 0, At, B0); PG8_BAR; PG8_SCHED;
            PG8_STAGE(PG8_SB(0, 1), b2 + hstep, voffB);
            PG8_WAIT_V(6); PG8_BAR; PG8_MMA(1, 1, At, B1); PG8_BAR;
            PG8_LDB(B0, 1, 0); PG8_SCHED; PG8_LDA(At, 1, 0); PG8_STAGE(PG8_SA(0, 1), a2 + hstep, voffA);
            PG8_WAIT_L(8); PG8_BAR; PG8_WAIT_L(0); PG8_MMA(0, 0, At, B0); PG8_BAR; PG8_SCHED;
            PG8_LDB(B1, 1, 1); PG8_STAGE(PG8_SB(1, 0), b3, voffB);
            PG8_BAR; PG8_WAIT_L(0); PG8_MMA(0, 1, At, B1); PG8_BAR;
            PG8_LDA(At, 1, 1); PG8_STAGE(PG8_SA(1, 0), a3, voffA);
            PG8_BAR; PG8_WAIT_L(0); PG8_MMA(1, 0, At, B0); PG8_BAR; PG8_SCHED;
            PG8_STAGE(PG8_SB(1, 1), b3 + hstep, voffB);
            PG8_WAIT_V(6); PG8_BAR; PG8_MMA(1, 1, At, B1); PG8_BAR;
            }
        }
        if constexpr (F8W != 0) asm volatile("s_nop 15\n\ts_nop 15\n\ts_nop 15\n\ts_nop 15" ::: "memory");
        if constexpr (ALIGN_EPI) { if (wr == 0) PG8_BAR; }
        if constexpr (!Epi::AFTER_DRAIN) { E(acc, cur, wr, wc, fr, fq); S.done(cur); }
        if (!has_next) break;
#pragma unroll
        for (int a = 0; a < 2; ++a)
#pragma unroll
            for (int b = 0; b < 2; ++b)
#pragma unroll
                for (int m = 0; m < 4; ++m)
#pragma unroll
                    for (int n = 0; n < 2; ++n) acc[a][b][m][n] = (f32x4){0.f, 0.f, 0.f, 0.f};
        cur = nxt; cA = nA; cB = nB; ++ui;
        if constexpr (ALIGN_EPI) { if (wr == 1) PG8_BAR; }
    }
    PG8_WAIT_V(0);
    if constexpr (!ALIGN_EPI) { if (wr == 0) PG8_BAR; }
    PG8_BAR;
    if constexpr (Epi::AFTER_DRAIN) { E.fused(acc, cur, wr, wc, fr, fq, lds, wid, lane); S.done(cur); }
#undef PG8_SA
#undef PG8_SB
#undef PG8_STAGE
#undef PG8_LDA
#undef PG8_LD1
#undef PG8_LDB
#undef PG8_MMA
#undef PG8_WAIT_V
#undef PG8_WAIT_L
#undef PG8_BAR
#undef PG8_SCHED
}
}

#define XB_TMO      128
#define XB_XCNT(j)  (256  + 64 * (j))
#define XB_XSUB(j)  (1280 + 64 * (j))
#define XB_XGEN(j)  (2304 + 64 * (j))
#define XB_TOP      3328
#define XB_TOPGEN   3392
#define XCD_BAR_WORDS 3456
#define XB_SPIN_CAP (1u << 18)

__device__ __forceinline__ unsigned xb_ld(unsigned* p)              { return __hip_atomic_load(p, __ATOMIC_RELAXED, __HIP_MEMORY_SCOPE_AGENT); }
__device__ __forceinline__ unsigned xb_add(unsigned* p, unsigned v) { return __hip_atomic_fetch_add(p, v, __ATOMIC_RELAXED, __HIP_MEMORY_SCOPE_AGENT); }
__device__ __forceinline__ unsigned xb_xcc_id() { return (unsigned)__builtin_amdgcn_s_getreg((3 << 11) | 20) & 0xFu; }
#define XB_SPIN(cond, bar) do { unsigned _sp = 0; while (cond) { __builtin_amdgcn_s_sleep(1); \
    if ((++_sp & 255u) == 0u) { if (xb_ld(&(bar)[XB_TMO])) break; if (_sp > XB_SPIN_CAP) { atomicAdd(&(bar)[XB_TMO], 1u); break; } } } } while (0)

struct XcdBarrier {
    unsigned* bar; unsigned x;
    volatile LAS unsigned* st;
};

__device__ __forceinline__ XcdBarrier xcd_barrier_post(unsigned* bar, volatile LAS unsigned* st) {
    XcdBarrier b; b.bar = bar; b.x = xb_xcc_id(); b.st = st;
    if (threadIdx.x == 0) (void)xb_add(&bar[XB_XCNT(b.x)], 1u);
    return b;
}
__device__ __forceinline__ void xcd_barrier_complete(unsigned* bar, unsigned x, unsigned& nloc, unsigned& nx) {
    const unsigned G = gridDim.x * gridDim.y * gridDim.z;
    unsigned sum, cnt, mine, sp = 0u;
    for (;;) {
        sum = 0u; cnt = 0u; mine = 0u;
#pragma unroll
        for (unsigned j = 0; j < 16; ++j) { const unsigned c = xb_ld(&bar[XB_XCNT(j)]); sum += c; cnt += (c > 0u) ? 1u : 0u; mine = (j == x) ? c : mine; }
        if (sum == G) break;
        __builtin_amdgcn_s_sleep(1);
        if ((++sp & 255u) == 0u) { if (xb_ld(&bar[XB_TMO])) break; if (sp > XB_SPIN_CAP) { atomicAdd(&bar[XB_TMO], 1u); break; } }
    }
    nloc = mine > 0u ? mine : 1u; nx = cnt > 0u ? cnt : 1u;
}

__device__ __forceinline__ void xcd_barrier(const XcdBarrier& b) {
    asm volatile("s_waitcnt vmcnt(0)" ::: "memory");
    __syncthreads();
    if (threadIdx.x == 0) {
        unsigned* bar = b.bar;
        __builtin_amdgcn_s_waitcnt(0);
        unsigned nloc = b.st[0], nx = b.st[1];
        if (nloc == 0u) { xcd_barrier_complete(bar, b.x, nloc, nx); b.st[0] = nloc; b.st[1] = nx; }
        const unsigned old = xb_add(&bar[XB_XSUB(b.x)], 1u);
        const unsigned gen = old / nloc;
        if (old + 1u == (gen + 1u) * nloc) {
            __builtin_amdgcn_fence(__ATOMIC_RELEASE, "agent");
            asm volatile("s_waitcnt vmcnt(0)" ::: "memory");
            const unsigned og = xb_add(&bar[XB_TOP], 1u);
            const unsigned tg = og / nx;
            if (og + 1u == (tg + 1u) * nx) xb_add(&bar[XB_TOPGEN], 1u);
            else XB_SPIN(xb_ld(&bar[XB_TOPGEN]) == tg, bar);
            __builtin_amdgcn_fence(__ATOMIC_ACQUIRE, "agent");
            xb_add(&bar[XB_XGEN(b.x)], 1u);
            asm volatile("s_waitcnt vmcnt(0)" ::: "memory");
        } else {
            XB_SPIN(xb_ld(&bar[XB_XGEN(b.x)]) == gen, bar);
            __builtin_amdgcn_fence(__ATOMIC_ACQUIRE, "agent");
            asm volatile("s_waitcnt vmcnt(0)" ::: "memory");
        }
    }
    __syncthreads();
}

template <int NT>
__device__ __forceinline__ void rms1_tokens(int t0, int lane, const float* __restrict__ x, const float* __restrict__ nw, const float* __restrict__ w_in,
                                            const float* __restrict__ a_log, const float* __restrict__ dt_bias, bf16* hn, float* beta, float* gl) {
    float4 v[NT][4]; float rs[NT];
#pragma unroll
    for (int u = 0; u < NT; ++u) { const float4* xr = (const float4*)(x + (size_t)(t0 + u) * D); float ss = 0.f;
#pragma unroll
        for (int j = 0; j < 4; ++j) { v[u][j] = xr[lane + 64 * j]; ss += v[u][j].x * v[u][j].x + v[u][j].y * v[u][j].y + v[u][j].z * v[u][j].z + v[u][j].w * v[u][j].w; }
        rs[u] = ss; }
#pragma unroll
    for (int u = 0; u < NT; ++u) rs[u] = rsqrtf(wave_sum(rs[u]) * (1.f / D) + EPS);
    float dots[NT][8];
#pragma unroll
    for (int u = 0; u < NT; ++u)
#pragma unroll
        for (int c = 0; c < 8; ++c) dots[u][c] = 0.f;
#pragma unroll
    for (int j = 0; j < 4; ++j) {
        const int e = 4 * (lane + 64 * j);
        const float4 w = ((const float4*)nw)[lane + 64 * j];
        float h[NT][4];
#pragma unroll
        for (int u = 0; u < NT; ++u) { const float r = rs[u]; h[u][0] = v[u][j].x * r * w.x; h[u][1] = v[u][j].y * r * w.y; h[u][2] = v[u][j].z * r * w.z; h[u][3] = v[u][j].w * r * w.w;
            uint2 o; o.x = pk2(h[u][0], h[u][1]); o.y = pk2(h[u][2], h[u][3]);
            *(uint2*)(hn + (size_t)(t0 + u) * D + e) = o; }
#pragma unroll
        for (int i = 0; i < 4; ++i) {
            const float4* wr = (const float4*)(w_in + (size_t)(e + i) * IN_COLS + OFF_B);
            const float4 w0 = wr[0], w1 = wr[1];
#pragma unroll
            for (int u = 0; u < NT; ++u) { const float hh = h[u][i];
                dots[u][0] += hh * w0.x; dots[u][1] += hh * w0.y; dots[u][2] += hh * w0.z; dots[u][3] += hh * w0.w;
                dots[u][4] += hh * w1.x; dots[u][5] += hh * w1.y; dots[u][6] += hh * w1.z; dots[u][7] += hh * w1.w; }
        }
    }
#pragma unroll
    for (int u = 0; u < NT; ++u) {
#pragma unroll
        for (int c = 0; c < 8; ++c) dots[u][c] = wave_sum(dots[u][c]);
        if (lane < 4) {
            const float d = lane == 0 ? dots[u][0] : lane == 1 ? dots[u][1] : lane == 2 ? dots[u][2] : dots[u][3];
            beta[(t0 + u) * 4 + lane] = sigmoidf_(d);
            const float a = lane == 0 ? dots[u][4] : lane == 1 ? dots[u][5] : lane == 2 ? dots[u][6] : dots[u][7];
            gl[(t0 + u) * 4 + lane] = -__expf(a_log[lane]) * softplusf_(a + dt_bias[lane]);
        }
    }
}

__device__ __forceinline__ float conf_glu(const bf16* proj, int t, int c) {
    const float a = bf2f(proj[(size_t)t * PC + 2048 + c]), g = bf2f(proj[(size_t)t * PC + 2560 + c]);
    return a * sigmoidf_(g);
}
__device__ __forceinline__ void conf_tile(int tile, const bf16* proj, const float* __restrict__ dw, const float* __restrict__ db, const float* __restrict__ lw, const float* __restrict__ lb,
                                          bf16* mix, float* red  ) {
    const int c = threadIdx.x, wave = threadIdx.x >> 6, lane = threadIdx.x & 63;
    const int b = tile / (S / 64), s0 = (tile % (S / 64)) * 64, t0 = b * S + s0;
    float wj[CFK];
#pragma unroll
    for (int j = 0; j < CFK; ++j) wj[j] = dw[j * CF + c];
    const float bias = db[c], lnw = lw[c], lnb = lb[c];
    float win[38];
    unsigned short ra[8], rg[8];
#pragma unroll
    for (int i = 0; i < 8; ++i) { ra[i] = proj[(size_t)(t0 + i) * PC + 2048 + c]; rg[i] = proj[(size_t)(t0 + i) * PC + 2560 + c]; }
#pragma unroll
    for (int i = 0; i < 30; ++i) win[i] = (s0 - 30 + i >= 0) ? conf_glu(proj, t0 - 30 + i, c) : 0.f;
    for (int blk = 0; blk < 8; ++blk) {
#pragma unroll
        for (int i = 0; i < 8; ++i) win[30 + i] = bf2f(ra[i]) * sigmoidf_(bf2f(rg[i]));
        if (blk < 7) {
#pragma unroll
            for (int i = 0; i < 8; ++i) { ra[i] = proj[(size_t)(t0 + blk * 8 + 8 + i) * PC + 2048 + c]; rg[i] = proj[(size_t)(t0 + blk * 8 + 8 + i) * PC + 2560 + c]; }
        }
        float o[8];
#pragma unroll
        for (int i = 0; i < 8; ++i) { float a = bias;
#pragma unroll
            for (int j = 0; j < CFK; ++j) a += wj[j] * win[i + j];
            o[i] = a; }
        float* ob = red; float* st = red + 8 * CF;
#pragma unroll
        for (int i = 0; i < 8; ++i) ob[i * CF + c] = o[i];
        __syncthreads();
        { float s1 = 0.f, s2 = 0.f;
#pragma unroll
          for (int k = 0; k < 8; ++k) { const float v = ob[wave * CF + lane + 64 * k]; s1 += v; s2 += v * v; }
          s1 = wave_sum(s1); s2 = wave_sum(s2);
          if (lane == 0) { const float mu = s1 * (1.f / CF), var = fmaxf(s2 * (1.f / CF) - mu * mu, 0.f); st[2 * wave] = mu; st[2 * wave + 1] = rsqrtf(var + EPS); } }
        __syncthreads();
#pragma unroll
        for (int i = 0; i < 8; ++i) {
            const float y = (o[i] - st[2 * i]) * st[2 * i + 1] * lnw + lnb;
            mix[(size_t)(t0 + blk * 8 + i) * D + 512 + c] = (bf16)f2bf(siluf_(y));
        }
#pragma unroll
        for (int i = 0; i < 30; ++i) win[i] = win[i + 8];
    }
    __syncthreads();
}

typedef short bf16x8 __attribute__((ext_vector_type(8)));
typedef float f32x4 __attribute__((ext_vector_type(4)));
typedef unsigned u32x2 __attribute__((ext_vector_type(2)));
__device__ __forceinline__ f32x4 mfma16(bf16x8 a, bf16x8 b, f32x4 c) { return __builtin_amdgcn_mfma_f32_16x16x32_bf16(a, b, c, 0, 0, 0); }
__device__ __forceinline__ bf16x8 as_bf16x8(v4u v) { return __builtin_bit_cast(bf16x8, v); }
__device__ __forceinline__ void rms2_group(int grp, const bf16* xmid, const float* __restrict__ nw, const v4u* wrh, const v4u* wrl, const float* __restrict__ br, unsigned char* xn, int* tope, float* topg, int* ghist, unsigned char* sm) {
    float* rr = (float*)sm; float* lg = (float*)(sm + 256); int* lhist = (int*)(sm + 8704);
    const int tid = threadIdx.x, wave = __builtin_amdgcn_readfirstlane(tid >> 6), lane = tid & 63, tb = grp * 64;
    if (tid < NE) lhist[tid] = 0;
    {
        uint4 xa[8], xb[8];
#pragma unroll
        for (int i = 0; i < 8; ++i) { const uint4* xr = (const uint4*)(xmid + (size_t)(tb + 8 * wave + i) * D + 16 * lane); xa[i] = xr[0]; xb[i] = xr[1]; }
        float4 w4[4];
#pragma unroll
        for (int j = 0; j < 4; ++j) w4[j] = ((const float4*)(nw + 16 * lane))[j];
#pragma unroll
        for (int i = 0; i < 8; ++i) {
            const uint4 a = xa[i], b = xb[i];
            float v[16] = {bf2f(a.x & 0xffffu), bf2f(a.x >> 16), bf2f(a.y & 0xffffu), bf2f(a.y >> 16), bf2f(a.z & 0xffffu), bf2f(a.z >> 16), bf2f(a.w & 0xffffu), bf2f(a.w >> 16),
                           bf2f(b.x & 0xffffu), bf2f(b.x >> 16), bf2f(b.y & 0xffffu), bf2f(b.y >> 16), bf2f(b.z & 0xffffu), bf2f(b.z >> 16), bf2f(b.w & 0xffffu), bf2f(b.w >> 16)};
            float ss = 0.f;
#pragma unroll
            for (int j = 0; j < 16; ++j) ss += v[j] * v[j];
            const float r = rsqrtf(wave_sum(ss) * (1.f / D) + EPS);
            if (lane == 0) rr[8 * wave + i] = r;
            int o[4];
#pragma unroll
            for (int j = 0; j < 4; ++j) { const float4 w = w4[j];
                int p = 0; p = __builtin_amdgcn_cvt_pk_fp8_f32(v[4 * j] * r * w.x, v[4 * j + 1] * r * w.y, p, false); p = __builtin_amdgcn_cvt_pk_fp8_f32(v[4 * j + 2] * r * w.z, v[4 * j + 3] * r * w.w, p, true); o[j] = p; }
            *(int4*)(xn + (size_t)(tb + 8 * wave + i) * D + 16 * lane) = make_int4(o[0], o[1], o[2], o[3]);
        }
    }
    {
        const int r = lane & 15, q = lane >> 4, tt = wave >> 1, nt = wave & 1;
        const bf16* xrow = xmid + (size_t)(tb + 16 * tt + r) * D + 8 * q;
        f32x4 acc = (f32x4){0.f, 0.f, 0.f, 0.f};
#pragma unroll 1
        for (int k8 = 0; k8 < 32; k8 += 8) {
            v4u av[8], bh[8], bl[8];
#pragma unroll
            for (int u = 0; u < 8; ++u) { av[u] = *(const v4u*)(xrow + 32 * (k8 + u)); bh[u] = wrh[((k8 + u) * 2 + nt) * 64 + lane]; bl[u] = wrl[((k8 + u) * 2 + nt) * 64 + lane]; }
#pragma unroll
            for (int u = 0; u < 8; ++u) { acc = mfma16(as_bf16x8(av[u]), as_bf16x8(bh[u]), acc); acc = mfma16(as_bf16x8(av[u]), as_bf16x8(bl[u]), acc); }
        }
        __syncthreads();
        const float bb = br[16 * nt + r];
#pragma unroll
        for (int ii = 0; ii < 4; ++ii) { const int tok = 16 * tt + 4 * q + ii; lg[tok * 33 + 16 * nt + r] = acc[ii] * rr[tok] + bb; }
    }
    __syncthreads();
    if (tid < 64) {
        const float* l = lg + tid * 33;
        int ti[4]; float tv[4];
#pragma unroll
        for (int k = 0; k < 4; ++k) {
            float best = -INFINITY; int bi = 0;
            for (int x = 0; x < NE; ++x) { const bool taken = (k > 0 && ti[0] == x) || (k > 1 && ti[1] == x) || (k > 2 && ti[2] == x); const float v = l[x]; if (!taken && v > best) { best = v; bi = x; } }
            ti[k] = bi; tv[k] = best;
        }
        const float e1 = __expf(tv[1] - tv[0]), e2 = __expf(tv[2] - tv[0]), e3 = __expf(tv[3] - tv[0]);
        const float inv = 1.f / (1.f + e1 + e2 + e3);
        const int t = tb + tid;
        *(int4*)(tope + t * 4) = make_int4(ti[0], ti[1], ti[2], ti[3]);
        *(float4*)(topg + t * 4) = make_float4(inv, e1 * inv, e2 * inv, e3 * inv);
        atomicAdd(&lhist[ti[0]], 1); atomicAdd(&lhist[ti[1]], 1); atomicAdd(&lhist[ti[2]], 1); atomicAdd(&lhist[ti[3]], 1);
    }
    __syncthreads();
    if (tid < NE) ghist[grp * NE + tid] = lhist[tid];
    __syncthreads();
}

__device__ __forceinline__ void route_group(int grp, const int* ghist, const int* tope, const float* topg, const unsigned char* xn, int* pos, float* rgate, int* blke, unsigned char* xg, int* sm) {
    int* ptot = sm; int* ppre = sm + 512; int* tot = sm + 1024; int* pre = tot + 32; int* base = pre + 32; int* pe = base + 32; int* ppos = pe + 256;
    const int tid = threadIdx.x, nth = blockDim.x;
    if (tid < 256) pe[tid] = tope[grp * 256 + tid];
    { const int e = tid & 31, part = tid >> 5; int a = 0, p = 0;
#pragma unroll 4
      for (int w = part * 16; w < part * 16 + 16; ++w) { const int v = ghist[w * NE + e]; a += v; if (w < grp) p += v; }
      ptot[part * 32 + e] = a; ppre[part * 32 + e] = p; }
    __syncthreads();
    if (tid < NE) { int a = 0, p = 0;
#pragma unroll
        for (int part = 0; part < 16; ++part) { a += ptot[part * 32 + tid]; p += ppre[part * 32 + tid]; }
        tot[tid] = a; pre[tid] = p; }
    __syncthreads();
    if (tid == 0) {
        int blk = 0;
        for (int e = 0; e < NE; ++e) { base[e] = blk * RB; const int nb = (tot[e] + RB - 1) / RB; if (grp == 0) for (int q = 0; q < nb; ++q) blke[blk + q] = e; blk += nb; }
        if (grp == 0) blke[MAXBLK] = blk;
    }
    __syncthreads();
    if (tid < 256) {
        const int e = pe[tid]; int rank = 0;
        for (int p = 0; p < tid; ++p) rank += (pe[p] == e) ? 1 : 0;
        const int pp = base[e] + pre[e] + rank;
        ppos[tid] = pp; pos[grp * 256 + tid] = pp; rgate[pp] = topg[grp * 256 + tid];
    }
    __syncthreads();
    const int wave = tid >> 6, lane = tid & 63, nwave = nth >> 6;
    for (int p0 = wave * 8; p0 < 256; p0 += nwave * 8) {
        v4u v[8]; int dp[8];
#pragma unroll
        for (int u = 0; u < 8; ++u) { const int p = p0 + u; const int t = grp * 64 + (p >> 2); v[u] = ((const v4u*)(xn + (size_t)t * D))[lane]; dp[u] = ppos[p]; }
#pragma unroll
        for (int u = 0; u < 8; ++u) ((v4u*)(xg + (size_t)dp[u] * D))[lane] = v[u];
    }
    if (grp < NE) {
        const int e = grp, r0 = base[e] + tot[e], r1 = base[e] + ((tot[e] + RB - 1) / RB) * RB;
        for (int r = r0 + wave; r < r1; r += nwave) { uint4* dst = (uint4*)(xg + (size_t)r * D); dst[lane] = make_uint4(0, 0, 0, 0); if (lane == 0) rgate[r] = 0.f; }
    }
    __syncthreads();
}

__device__ __forceinline__ void combine_token(int t, int lane, const bf16* xmid, const bf16* y, const int* pos, const float* __restrict__ fw, float* out) {
    const uint2* xr = (const uint2*)(xmid + (size_t)t * D);
    const int4 pp = *(const int4*)(pos + t * 4);
    const int pr[4] = {pp.x, pp.y, pp.z, pp.w};
    float4 v[4]; float ss = 0.f;
#pragma unroll
    for (int j = 0; j < 4; ++j) {
        { const uint2 xx = xr[lane + 64 * j]; v[j] = make_float4(bf2f(xx.x & 0xffffu), bf2f(xx.x >> 16), bf2f(xx.y & 0xffffu), bf2f(xx.y >> 16)); }
#pragma unroll
        for (int k = 0; k < 4; ++k) { const uint2 q = *(const uint2*)(y + (size_t)pr[k] * D + 4 * (lane + 64 * j));
            v[j].x += bf2f(q.x & 0xffffu); v[j].y += bf2f(q.x >> 16); v[j].z += bf2f(q.y & 0xffffu); v[j].w += bf2f(q.y >> 16); }
        ss += v[j].x * v[j].x + v[j].y * v[j].y + v[j].z * v[j].z + v[j].w * v[j].w;
    }
    const float r = rsqrtf(wave_sum(ss) * (1.f / D) + EPS);
#pragma unroll
    for (int j = 0; j < 4; ++j) { const float4 w = ((const float4*)fw)[lane + 64 * j];
        ((float4*)(out + (size_t)t * D))[lane + 64 * j] = make_float4(v[j].x * r * w.x, v[j].y * r * w.y, v[j].z * r * w.z, v[j].w * r * w.w); }
}

constexpr int GP_KN = 0, GP_QN = 17408, GP_VC = 34816, GP_AM = 52224, GP_IM = 69632, GP_UT = 78848, GP_WT = 97280, GP_KT = 115712, GP_GC = 134144, GP_BT = 134400, GP_TI = 134656, GP_END = 143872;
static_assert(GP_WT == GP_UT + 128 * 144, "uT and wT must be contiguous");
constexpr int AMS = 68;
constexpr int RS = 272, TS = 144;

__device__ __forceinline__ void gdn_prep_task(int task, LAS unsigned char* L, const bf16* proj, const float* __restrict__ cw, const float* beta, const float* gl,
                                              v4u* Pf, v4u* Qc, v4u* RTf, f32x4* O0c) {
    const int tid = threadIdx.x, lane = tid & 63, wave = __builtin_amdgcn_readfirstlane(tid >> 6), r = lane & 15, q = lane >> 4;
    const int bh = task >> 7, n = task & 127, b = bh >> 2, h = bh & 3, s0 = n * 64, t0 = b * S + s0;
    LAS float* gcs = (LAS float*)(L + GP_GC); LAS float* bts = (LAS float*)(L + GP_BT);
    {
        float g = gl[(t0 + lane) * 4 + h];
#pragma unroll
        for (int o = 1; o < 64; o <<= 1) { const float v = __shfl_up(g, o); if (lane >= o) g += v; }
        const float bt = beta[(t0 + lane) * 4 + h];
        if (wave == 0) { gcs[lane] = g; bts[lane] = bt; }
        const int i0 = 8 * wave, cb = h * 128 + 2 * lane;
        float wq[4][2], wk[4][2], wv[4][2];
#pragma unroll
        for (int j = 0; j < 4; ++j) { const float2 a = *(const float2*)(cw + j * 1536 + cb), bb = *(const float2*)(cw + j * 1536 + 512 + cb), c = *(const float2*)(cw + j * 1536 + 1024 + cb);
            wq[j][0] = a.x; wq[j][1] = a.y; wk[j][0] = bb.x; wk[j][1] = bb.y; wv[j][0] = c.x; wv[j][1] = c.y; }
        unsigned rq[11], rk[11], rv[11];
#pragma unroll
        for (int rho = 0; rho < 11; ++rho) {
            const int s = s0 + i0 - 3 + rho;
            if (s >= 0) { const bf16* p = proj + (size_t)(t0 + i0 - 3 + rho) * PC + cb; rq[rho] = *(const unsigned*)p; rk[rho] = *(const unsigned*)(p + 512); rv[rho] = *(const unsigned*)(p + 1024); }
            else { rq[rho] = 0u; rk[rho] = 0u; rv[rho] = 0u; }
        }
#pragma unroll
        for (int ii = 0; ii < 8; ++ii) {
            float q0 = 0.f, q1 = 0.f, k0 = 0.f, k1 = 0.f, v0 = 0.f, v1 = 0.f;
#pragma unroll
            for (int j = 0; j < 4; ++j) {
                q0 += wq[j][0] * bf2f(rq[ii + j] & 0xffffu); q1 += wq[j][1] * bf2f(rq[ii + j] >> 16);
                k0 += wk[j][0] * bf2f(rk[ii + j] & 0xffffu); k1 += wk[j][1] * bf2f(rk[ii + j] >> 16);
                v0 += wv[j][0] * bf2f(rv[ii + j] & 0xffffu); v1 += wv[j][1] * bf2f(rv[ii + j] >> 16);
            }
            q0 = siluf_(q0); q1 = siluf_(q1); k0 = siluf_(k0); k1 = siluf_(k1); v0 = siluf_(v0); v1 = siluf_(v1);
            const float sq = rsqrtf(wave_sum(q0 * q0 + q1 * q1) + EPS) * 0.08838834764831845f, sk = rsqrtf(wave_sum(k0 * k0 + k1 * k1) + EPS);
            const int ro = (i0 + ii) * RS + 4 * lane;
            *(LAS unsigned*)(L + GP_QN + ro) = pk2(q0 * sq, q1 * sq);
            *(LAS unsigned*)(L + GP_KN + ro) = pk2(k0 * sk, k1 * sk);
            *(LAS unsigned*)(L + GP_VC + ro) = pk2(v0, v1);
        }
    }
    __syncthreads();
    {
        const int ti = wave >> 1, tj0 = (wave & 1) * 2;
        f32x4 kk[2], qk[2];
#pragma unroll
        for (int u = 0; u < 2; ++u) { kk[u] = (f32x4){0.f, 0.f, 0.f, 0.f}; qk[u] = (f32x4){0.f, 0.f, 0.f, 0.f}; }
#pragma unroll
        for (int s = 0; s < 4; ++s) {
            const int co = (32 * s + 8 * q) * 2;
            const bf16x8 ak = *(const LAS bf16x8*)(L + GP_KN + (16 * ti + r) * RS + co), aq = *(const LAS bf16x8*)(L + GP_QN + (16 * ti + r) * RS + co);
#pragma unroll
            for (int u = 0; u < 2; ++u) { const bf16x8 bk = *(const LAS bf16x8*)(L + GP_KN + (16 * (tj0 + u) + r) * RS + co); kk[u] = mfma16(ak, bk, kk[u]); qk[u] = mfma16(aq, bk, qk[u]); }
        }
#pragma unroll
        for (int u = 0; u < 2; ++u) {
            const int j = 16 * (tj0 + u) + r; const float gcj = gcs[j];
#pragma unroll
            for (int ii = 0; ii < 4; ++ii) {
                const int i = 16 * ti + 4 * q + ii; const float gci = gcs[i], bti = bts[i];
                const float dec = (i >= j) ? __expf(gci - gcj) : 0.f;
                *(LAS float*)(L + GP_AM + (i * AMS + j) * 4) = (i > j) ? bti * kk[u][ii] * dec : 0.f;
                *(LAS unsigned short*)(L + GP_IM + i * TS + j * 2) = (unsigned short)f2bf(qk[u][ii] * dec);
            }
        }
    }
    __syncthreads();
    {
        float Ac[64];
#pragma unroll
        for (int j4 = 0; j4 < 64; j4 += 4) { const f32x4 av = *(const LAS f32x4*)(L + GP_AM + (lane * AMS + j4) * 4); Ac[j4] = av[0]; Ac[j4 + 1] = av[1]; Ac[j4 + 2] = av[2]; Ac[j4 + 3] = av[3]; }
        const float bti = bts[lane], gci = gcs[lane], ekt = __expf(gcs[63] - gci), ew = bti * __expf(gci);
        const int ca = 4 * wave, cb2 = 60 - 4 * wave;
        float xa[4], xb[4];
#pragma unroll
        for (int c = 0; c < 4; ++c) { xa[c] = (lane == ca + c) ? 1.f : 0.f; xb[c] = (lane == cb2 + c) ? 1.f : 0.f; }
#pragma unroll
        for (int jc = 0; jc < 8; ++jc) {
            if (8 * jc + 7 >= ca) {
#pragma unroll
                for (int jj = 0; jj < 8; ++jj) { const int j = 8 * jc + jj; if (j < 63) {
#pragma unroll
                    for (int c = 0; c < 4; ++c) { const float xj = __builtin_bit_cast(float, __builtin_amdgcn_readlane(__builtin_bit_cast(int, xa[c]), j)); xa[c] -= Ac[j] * xj; } } }
            }
            if (8 * jc + 7 >= cb2) {
#pragma unroll
                for (int jj = 0; jj < 8; ++jj) { const int j = 8 * jc + jj; if (j < 63) {
#pragma unroll
                    for (int c = 0; c < 4; ++c) { const float xj = __builtin_bit_cast(float, __builtin_amdgcn_readlane(__builtin_bit_cast(int, xb[c]), j)); xb[c] -= Ac[j] * xj; } } }
            }
        }
        { u32x2 o; o.x = pk2(xa[0], xa[1]); o.y = pk2(xa[2], xa[3]); *(LAS u32x2*)(L + GP_TI + lane * TS + ca * 2) = o;
          o.x = pk2(xb[0], xb[1]); o.y = pk2(xb[2], xb[3]); *(LAS u32x2*)(L + GP_TI + lane * TS + cb2 * 2) = o; }
#pragma unroll 1
        for (int gi = 0; gi < 4; ++gi) {
            const int cg = wave * 4 + gi, col0 = 8 * cg;
            const bool isw = col0 >= 128; const int cc = isw ? col0 - 128 : col0;
            const v4u raw = *(const LAS v4u*)(L + (isw ? GP_KN : GP_VC) + lane * RS + cc * 2);
            const float sc = isw ? ew : bti;
            const float x[8] = {bf2f(raw.x & 0xffffu) * sc, bf2f(raw.x >> 16) * sc, bf2f(raw.y & 0xffffu) * sc, bf2f(raw.y >> 16) * sc,
                                bf2f(raw.z & 0xffffu) * sc, bf2f(raw.z >> 16) * sc, bf2f(raw.w & 0xffffu) * sc, bf2f(raw.w >> 16) * sc};
            LAS unsigned char* dst = L + (isw ? GP_WT : GP_UT) + cc * TS + lane * 2;
#pragma unroll
            for (int c = 0; c < 8; ++c) *(LAS unsigned short*)(dst + c * TS) = (unsigned short)f2bf(x[c]);
        }
#pragma unroll 1
        for (int gi = 0; gi < 2; ++gi) {
            const int d0 = 8 * (wave * 2 + gi);
            const v4u raw = *(const LAS v4u*)(L + GP_KN + lane * RS + d0 * 2);
            const float x[8] = {bf2f(raw.x & 0xffffu) * ekt, bf2f(raw.x >> 16) * ekt, bf2f(raw.y & 0xffffu) * ekt, bf2f(raw.y >> 16) * ekt,
                                bf2f(raw.z & 0xffffu) * ekt, bf2f(raw.z >> 16) * ekt, bf2f(raw.w & 0xffffu) * ekt, bf2f(raw.w >> 16) * ekt};
            LAS unsigned char* dst = L + GP_KT + d0 * TS + lane * 2;
#pragma unroll
            for (int c = 0; c < 8; ++c) *(LAS unsigned short*)(dst + c * TS) = (unsigned short)f2bf(x[c]);
        }
    }
    __syncthreads();
    {
        const int co0 = (8 * q) * 2, co1 = (32 + 8 * q) * 2;
        bf16x8 tb0[4], tb1[4];
#pragma unroll
        for (int tn = 0; tn < 4; ++tn) { tb0[tn] = *(const LAS bf16x8*)(L + GP_TI + (16 * tn + r) * TS + co0); tb1[tn] = *(const LAS bf16x8*)(L + GP_TI + (16 * tn + r) * TS + co1); }
#pragma unroll
        for (int u = 0; u < 2; ++u) {
            LAS unsigned char* rows = L + GP_UT + (16 * (2 * wave + u)) * TS;
            const bf16x8 a0 = *(const LAS bf16x8*)(rows + r * TS + co0), a1 = *(const LAS bf16x8*)(rows + r * TS + co1);
            f32x4 cc[4];
#pragma unroll
            for (int tn = 0; tn < 4; ++tn) { cc[tn] = (f32x4){0.f, 0.f, 0.f, 0.f}; cc[tn] = mfma16(a0, tb0[tn], cc[tn]); cc[tn] = mfma16(a1, tb1[tn], cc[tn]); }
#pragma unroll
            for (int tn = 0; tn < 4; ++tn)
#pragma unroll
                for (int ii = 0; ii < 4; ++ii) *(LAS unsigned short*)(rows + (4 * q + ii) * TS + (16 * tn + r) * 2) = (unsigned short)f2bf(cc[tn][ii]);
        }
    }
    __syncthreads();
    {
        const float gtot = __expf(gcs[63]);
        const int co0 = (8 * q) * 2, co1 = (32 + 8 * q) * 2;
        {
            const bf16x8 b0 = *(const LAS bf16x8*)(L + GP_KT + (16 * wave + r) * TS + co0), b1 = *(const LAS bf16x8*)(L + GP_KT + (16 * wave + r) * TS + co1);
#pragma unroll
            for (int s = 0; s < 4; ++s) {
                const LAS unsigned char* a0p = L + GP_WT + (32 * s + r) * TS; const LAS unsigned char* a1p = a0p + 16 * TS;
                f32x4 c0 = (f32x4){0.f, 0.f, 0.f, 0.f}, c1 = c0;
                c0 = mfma16(*(const LAS bf16x8*)(a0p + co0), b0, c0); c0 = mfma16(*(const LAS bf16x8*)(a0p + co1), b1, c0);
                c1 = mfma16(*(const LAS bf16x8*)(a1p + co0), b0, c1); c1 = mfma16(*(const LAS bf16x8*)(a1p + co1), b1, c1);
                float v0[4], v1[4];
#pragma unroll
                for (int ii = 0; ii < 4; ++ii) { v0[ii] = ((2 * s == wave && 4 * q + ii == r) ? gtot : 0.f) - c0[ii]; v1[ii] = ((2 * s + 1 == wave && 4 * q + ii == r) ? gtot : 0.f) - c1[ii]; }
                v4u o; o.x = pk2(v0[0], v0[1]); o.y = pk2(v0[2], v0[3]); o.z = pk2(v1[0], v1[1]); o.w = pk2(v1[2], v1[3]);
                Pf[((size_t)(task * 8 + wave) * 4 + s) * 64 + lane] = o;
            }
        }
        {
            const bf16x8 b0 = *(const LAS bf16x8*)(L + GP_UT + (16 * wave + r) * TS + co0), b1 = *(const LAS bf16x8*)(L + GP_UT + (16 * wave + r) * TS + co1);
#pragma unroll
            for (int tp = 0; tp < 4; ++tp) {
                const LAS unsigned char* ap = L + GP_KT + (32 * tp + r) * TS; const LAS unsigned char* ap2 = ap + 16 * TS;
                f32x4 c = (f32x4){0.f, 0.f, 0.f, 0.f}, c2 = c;
                c = mfma16(*(const LAS bf16x8*)(ap + co0), b0, c); c = mfma16(*(const LAS bf16x8*)(ap + co1), b1, c);
                c2 = mfma16(*(const LAS bf16x8*)(ap2 + co0), b0, c2); c2 = mfma16(*(const LAS bf16x8*)(ap2 + co1), b1, c2);
                v4u o; o.x = pk2(c[0], c[1]); o.y = pk2(c[2], c[3]); o.z = pk2(c2[0], c2[1]); o.w = pk2(c2[2], c2[3]);
                Qc[((size_t)(task * 8 + wave) * 4 + tp) * 64 + lane] = o;
            }
        }
        {
            const int tn = wave & 3, i = 16 * tn + r; const float egi = __expf(gcs[i]);
            const bf16x8 b0 = *(const LAS bf16x8*)(L + GP_IM + i * TS + co0), b1 = *(const LAS bf16x8*)(L + GP_IM + i * TS + co1);
#pragma unroll
            for (int sx = 0; sx < 2; ++sx) {
                const int s = 2 * (wave >> 2) + sx;
                const LAS unsigned char* a0p = L + GP_WT + (32 * s + r) * TS; const LAS unsigned char* a1p = a0p + 16 * TS;
                f32x4 c0 = (f32x4){0.f, 0.f, 0.f, 0.f}, c1 = c0;
                c0 = mfma16(*(const LAS bf16x8*)(a0p + co0), b0, c0); c0 = mfma16(*(const LAS bf16x8*)(a0p + co1), b1, c0);
                c1 = mfma16(*(const LAS bf16x8*)(a1p + co0), b0, c1); c1 = mfma16(*(const LAS bf16x8*)(a1p + co1), b1, c1);
                const u32x2 q0 = *(const LAS u32x2*)(L + GP_QN + i * RS + (32 * s + 4 * q) * 2), q1 = *(const LAS u32x2*)(L + GP_QN + i * RS + (32 * s + 16 + 4 * q) * 2);
                v4u o;
                o.x = pk2(bf2f(q0.x & 0xffffu) * egi - c0[0], bf2f(q0.x >> 16) * egi - c0[1]); o.y = pk2(bf2f(q0.y & 0xffffu) * egi - c0[2], bf2f(q0.y >> 16) * egi - c0[3]);
                o.z = pk2(bf2f(q1.x & 0xffffu) * egi - c1[0], bf2f(q1.x >> 16) * egi - c1[1]); o.w = pk2(bf2f(q1.y & 0xffffu) * egi - c1[2], bf2f(q1.y >> 16) * egi - c1[3]);
                RTf[((size_t)(task * 4 + tn) * 4 + s) * 64 + lane] = o;
            }
        }
        {
            const bf16x8 a0 = *(const LAS bf16x8*)(L + GP_UT + (16 * wave + r) * TS + co0), a1 = *(const LAS bf16x8*)(L + GP_UT + (16 * wave + r) * TS + co1);
#pragma unroll
            for (int tn = 0; tn < 4; ++tn) {
                const LAS unsigned char* bp = L + GP_IM + (16 * tn + r) * TS;
                f32x4 c = (f32x4){0.f, 0.f, 0.f, 0.f};
                c = mfma16(a0, *(const LAS bf16x8*)(bp + co0), c); c = mfma16(a1, *(const LAS bf16x8*)(bp + co1), c);
                O0c[((size_t)(task * 8 + wave) * 4 + tn) * 64 + lane] = c;
            }
        }
    }
    __syncthreads();
}

constexpr int CH_SLOT = 36864, CH_FLAGS = 3 * CH_SLOT;
__device__ __forceinline__ void ch_spin(volatile LAS int* w, int want) {
    unsigned sp = 0; while (*w < want) { __builtin_amdgcn_s_sleep(1); if (++sp > (1u << 22)) break; }
    asm volatile("" ::: "memory");
}
__device__ __forceinline__ void gdn_chain_loader(int lw, int bh, int c, int lane, LAS unsigned char* L, const v4u* Pf, const v4u* Qc) {
    volatile LAS int* FL = (volatile LAS int*)(L + CH_FLAGS);
    const int sl = lw >> 1, hf = lw & 1;
    LAS unsigned char* slot = L + sl * CH_SLOT;
    for (int m = sl; m < 128; m += 3) {
        if (m >= 3) ch_spin(FL + 8 + sl, m - 2);
        const int task = bh * 128 + m;
        const v4u* ps = Pf + (size_t)task * 2048 + hf * 1024 + lane; const v4u* qs = Qc + (size_t)(task * 8 + c) * 256 + hf * 128 + lane;
#pragma unroll
        for (int f = 0; f < 16; ++f) __builtin_amdgcn_global_load_lds((const unsigned*)(ps + f * 64), (LAS unsigned*)(slot + (16 * hf + f) * 1024), 16, 0, 0);
#pragma unroll
        for (int f = 0; f < 2; ++f) __builtin_amdgcn_global_load_lds((const unsigned*)(qs + f * 64), (LAS unsigned*)(slot + 32768 + (2 * hf + f) * 1024), 16, 0, 0);
        asm volatile("s_waitcnt vmcnt(0)" ::: "memory");
        if (lane == 0) FL[lw] = m + 1;
    }
}
__device__ __forceinline__ unsigned cvtpk(float lo, float hi) { unsigned r; asm volatile("v_cvt_pk_bf16_f32 %0, %1, %2" : "=v"(r) : "v"(lo), "v"(hi)); return r; }
__device__ __forceinline__ void gdn_chain_consumer(int bh, int c, int lane, LAS unsigned char* L, v4u* Sf_, unsigned* prog) {
    volatile LAS int* FL = (volatile LAS int*)(L + CH_FLAGS);
    const __amdgpu_buffer_rsrc_t srs = __builtin_amdgcn_make_buffer_rsrc((void*)Sf_, (short)0, 32 << 20, 0x00020000);
    f32x4 acc[8];
#pragma unroll
    for (int t = 0; t < 8; ++t) acc[t] = (f32x4){0.f, 0.f, 0.f, 0.f};
    int sl = 0;
    for (int n = 0; n < 128; ++n) {
        const int task = bh * 128 + n;
        v4u sf[4];
#pragma unroll
        for (int s = 0; s < 4; ++s) { sf[s].x = cvtpk(acc[2 * s][0], acc[2 * s][1]); sf[s].y = cvtpk(acc[2 * s][2], acc[2 * s][3]); sf[s].z = cvtpk(acc[2 * s + 1][0], acc[2 * s + 1][1]); sf[s].w = cvtpk(acc[2 * s + 1][2], acc[2 * s + 1][3]);
            __builtin_amdgcn_raw_buffer_store_b128(sf[s], srs, (int)((((task * 8 + c) * 4 + s) * 64 + lane) * 16), 0, 16); }
        if (n == 127) break;
        ch_spin(FL + 2 * sl, n + 1); ch_spin(FL + 2 * sl + 1, n + 1);
        const LAS unsigned char* slot = L + sl * CH_SLOT + lane * 16;
        v4u qa, pa[8], qb, pb[8];
        qa = *(const LAS v4u*)(slot + 32768);
#pragma unroll
        for (int f = 0; f < 8; ++f) pa[f] = *(const LAS v4u*)(slot + f * 1024);
#pragma unroll
        for (int tp = 0; tp < 4; tp += 2) {
            qb = *(const LAS v4u*)(slot + 32768 + (tp + 1) * 1024);
#pragma unroll
            for (int f = 0; f < 8; ++f) pb[f] = *(const LAS v4u*)(slot + (8 * (tp + 1) + f) * 1024);
            __builtin_amdgcn_sched_barrier(0);
            { f32x4 a0 = (f32x4){bf2f(qa.x & 0xffffu), bf2f(qa.x >> 16), bf2f(qa.y & 0xffffu), bf2f(qa.y >> 16)}, a1 = (f32x4){bf2f(qa.z & 0xffffu), bf2f(qa.z >> 16), bf2f(qa.w & 0xffffu), bf2f(qa.w >> 16)};
#pragma unroll
              for (int s = 0; s < 4; ++s) { a0 = mfma16(as_bf16x8(pa[s]), as_bf16x8(sf[s]), a0); a1 = mfma16(as_bf16x8(pa[4 + s]), as_bf16x8(sf[s]), a1); }
              acc[2 * tp] = a0; acc[2 * tp + 1] = a1; }
            __builtin_amdgcn_sched_barrier(0);
            if (tp + 2 < 4) { qa = *(const LAS v4u*)(slot + 32768 + (tp + 2) * 1024);
#pragma unroll
                for (int f = 0; f < 8; ++f) pa[f] = *(const LAS v4u*)(slot + (8 * (tp + 2) + f) * 1024); }
            __builtin_amdgcn_sched_barrier(0);
            { f32x4 a0 = (f32x4){bf2f(qb.x & 0xffffu), bf2f(qb.x >> 16), bf2f(qb.y & 0xffffu), bf2f(qb.y >> 16)}, a1 = (f32x4){bf2f(qb.z & 0xffffu), bf2f(qb.z >> 16), bf2f(qb.w & 0xffffu), bf2f(qb.w >> 16)};
#pragma unroll
              for (int s = 0; s < 4; ++s) { a0 = mfma16(as_bf16x8(pb[s]), as_bf16x8(sf[s]), a0); a1 = mfma16(as_bf16x8(pb[4 + s]), as_bf16x8(sf[s]), a1); }
              acc[2 * tp + 2] = a0; acc[2 * tp + 3] = a1; }
            __builtin_amdgcn_sched_barrier(0);
        }
        asm volatile("s_waitcnt vmcnt(4) lgkmcnt(0)" ::: "memory");
        if (lane == 0) { FL[8 + sl] = n + 1; __hip_atomic_store(prog, (unsigned)n, __ATOMIC_RELAXED, __HIP_MEMORY_SCOPE_AGENT); }
        sl = (sl == 2) ? 0 : sl + 1;
    }
    asm volatile("s_waitcnt vmcnt(0)" ::: "memory");
    if (lane == 0) __hip_atomic_store(prog, 128u, __ATOMIC_RELAXED, __HIP_MEMORY_SCOPE_AGENT);
}

__device__ __forceinline__ void gdn_out_wave(int task, int tn, int lane, const v4u* Sf, const v4u* RTf, const f32x4* O0c, const bf16* proj, const float* __restrict__ nw, bf16* mix) {
    const int r = lane & 15, q = lane >> 4, bh = task >> 7, n = task & 127, b = bh >> 2, h = bh & 3;
    bf16x8 bfr[4];
#pragma unroll
    for (int s = 0; s < 4; ++s) bfr[s] = as_bf16x8(RTf[((size_t)(task * 4 + tn) * 4 + s) * 64 + lane]);
    f32x4 o[8]; float ss = 0.f;
    v4u sfr[8][4];
#pragma unroll
    for (int c = 0; c < 8; ++c) { o[c] = O0c[((size_t)(task * 8 + c) * 4 + tn) * 64 + lane];
#pragma unroll
        for (int s = 0; s < 4; ++s) sfr[c][s] = Sf[((size_t)(task * 8 + c) * 4 + s) * 64 + lane]; }
    const size_t t = (size_t)b * S + n * 64 + 16 * tn + r;
    uint2 zz[8];
#pragma unroll
    for (int c = 0; c < 8; ++c) zz[c] = *(const uint2*)(proj + t * PC + 1536 + h * 128 + 16 * c + 4 * q);
    __builtin_amdgcn_sched_barrier(0);
#pragma unroll
    for (int c = 0; c < 8; ++c) {
        f32x4 a = o[c];
#pragma unroll
        for (int s = 0; s < 4; ++s) a = mfma16(as_bf16x8(sfr[c][s]), bfr[s], a);
        o[c] = a; ss += (a[0] * a[0] + a[1] * a[1]) + (a[2] * a[2] + a[3] * a[3]);
    }
    ss += __shfl_xor(ss, 16); ss += __shfl_xor(ss, 32);
    const float rr = rsqrtf(ss * (1.f / 128.f) + EPS);
#pragma unroll
    for (int c = 0; c < 8; ++c) {
        const int dv0 = 16 * c + 4 * q;
        const uint2 z = zz[c]; const float4 w = *(const float4*)(nw + dv0);
        uint2 y; y.x = pk2(o[c][0] * rr * w.x * siluf_(bf2f(z.x & 0xffffu)), o[c][1] * rr * w.y * siluf_(bf2f(z.x >> 16)));
        y.y = pk2(o[c][2] * rr * w.z * siluf_(bf2f(z.y & 0xffffu)), o[c][3] * rr * w.w * siluf_(bf2f(z.y >> 16)));
        *(uint2*)(mix + t * D + h * 128 + dv0) = y;
    }
}

constexpr int I_WIN = 16 * 96, I_WOUT = 16 * 32, I_WGU = 32 * 16 * 64, I_WD = 32 * 16 * 32, I_ALL = I_WIN + I_WOUT + I_WGU + I_WD;
struct CvItem { const float* src; unsigned char* dst; int ld; int kind; };
__device__ __forceinline__ CvItem cv_decode(int it, const float* w_in, const float* w_out, const float* wgu, const float* wd, bf16* winT, bf16* woutT, unsigned char* wguT, unsigned char* wdT) {
    CvItem d; int r = it;
    if (r < I_WIN) { const int kb = r / 96, nb = r % 96, k0 = 64 * kb; const int scol = nb < 64 ? 32 * nb : 2056 + 32 * (nb - 64);
        d.src = w_in + (size_t)k0 * IN_COLS + scol; d.ld = IN_COLS; d.dst = (unsigned char*)(winT + (size_t)(32 * nb) * 1024 + k0); d.kind = 0; return d; }
    r -= I_WIN;
    if (r < I_WOUT) { const int kb = r / 32, nb = r % 32, k0 = 64 * kb; d.src = w_out + (size_t)k0 * D + 32 * nb; d.ld = D; d.dst = (unsigned char*)(woutT + (size_t)(32 * nb) * 1024 + k0); d.kind = 0; return d; }
    r -= I_WOUT;
    if (r < I_WGU) { const int e = r / 1024, q = r % 1024, kb = q / 64, nb = q % 64, k0 = 64 * kb, n0 = 32 * nb;
        const int half = n0 / 1024, cc = n0 % 1024, pn = cc / 128, j0 = cc % 128, drow = e * 2048 + pn * 256 + half * 128 + j0;
        d.src = wgu + (size_t)e * 1024 * 2048 + (size_t)k0 * 2048 + n0; d.ld = 2048; d.dst = wguT + (size_t)drow * 1024 + k0; d.kind = 1; return d; }
    r -= I_WGU;
    { const int e = r / 512, q = r % 512, kb = q / 32, nb = q % 32, k0 = 64 * kb, n0 = 32 * nb;
      d.src = wd + (size_t)e * 1024 * 1024 + (size_t)k0 * 1024 + n0; d.ld = 1024; d.dst = wdT + (size_t)(e * 1024 + n0) * 1024 + k0; d.kind = 1; return d; }
}
__device__ __forceinline__ void cv_load(const CvItem& d, float (&r)[32], int lane) {
#pragma unroll
    for (int i = 0; i < 32; ++i) r[i] = d.src[(size_t)(2 * i + (lane >> 5)) * d.ld + (lane & 31)];
}
__device__ __forceinline__ void cv_store(const CvItem& d, const float (&r)[32], LAS float* scr, int lane) {
#pragma unroll
    for (int i = 0; i < 32; ++i) scr[(2 * i + (lane >> 5)) * 33 + (lane & 31)] = r[i];
    LDS_WAIT(); asm volatile("" ::: "memory");
    const int c = lane & 7;
    if (d.kind == 0) {
#pragma unroll
        for (int j = 0; j < 4; ++j) { const int n = (lane >> 3) + 8 * j; const LAS float* s = scr + (8 * c) * 33 + n;
            v4u o; o.x = pk2(s[0 * 33], s[1 * 33]); o.y = pk2(s[2 * 33], s[3 * 33]); o.z = pk2(s[4 * 33], s[5 * 33]); o.w = pk2(s[6 * 33], s[7 * 33]);
            *(v4u*)(d.dst + ((size_t)n * 1024 + 8 * c) * 2) = o; }
    } else {
#pragma unroll
        for (int j = 0; j < 4; ++j) { const int n = (lane >> 3) + 8 * j; const LAS float* s = scr + (8 * c) * 33 + n;
            int w0 = 0, w1 = 0;
            w0 = __builtin_amdgcn_cvt_pk_fp8_f32(32.f * s[0 * 33], 32.f * s[1 * 33], w0, false); w0 = __builtin_amdgcn_cvt_pk_fp8_f32(32.f * s[2 * 33], 32.f * s[3 * 33], w0, true);
            w1 = __builtin_amdgcn_cvt_pk_fp8_f32(32.f * s[4 * 33], 32.f * s[5 * 33], w1, false); w1 = __builtin_amdgcn_cvt_pk_fp8_f32(32.f * s[6 * 33], 32.f * s[7 * 33], w1, true);
            *(u32x2*)(d.dst + (size_t)n * 1024 + 8 * c) = (u32x2){(unsigned)w0, (unsigned)w1}; }
    }
    LDS_WAIT(); asm volatile("" ::: "memory");
}
__device__ __forceinline__ void cv_run(int it0, int it_end, int step, const float* w_in, const float* w_out, const float* wgu, const float* wd, bf16* winT, bf16* woutT, unsigned char* wguT, unsigned char* wdT, LAS float* scr, int lane) {
    for (int it = it0; it < it_end; it += step) {
        const CvItem cur = cv_decode(it, w_in, w_out, wgu, wd, winT, woutT, wguT, wdT);
        float r[32]; cv_load(cur, r, lane);
        cv_store(cur, r, scr, lane);
    }
}

constexpr int NWAVES = 8;
constexpr int RING_OFF = 0, RING_BYTES = 131072;
constexpr int LDSCTL_OFF = 144384, MISC_OFF = LDSCTL_OFF + 320;
static_assert(GP_END <= LDSCTL_OFF, "LDS map");
constexpr int LDS_BYTES = 147456;
constexpr int NGOUT = 48;
constexpr int CW_PROG = 65536;
constexpr int CW_BAR = 4096;
enum Phase { PH_PRO = 0, PH_PROJ = 1, PH_CONF = 2, PH_GPREP = 3, PH_GCHAIN = 4, PH_GOUT = 5, PH_OUT = 6, PH_RMS2 = 7, PH_ROUTE = 8, PH_MOE1 = 9, PH_MOE2 = 10, PH_COMB = 11 };
struct Args { const float* in[20]; float* out; unsigned char* ws; unsigned mask; int li; };

__global__ void __launch_bounds__(NWAVES * 64, 2) mega(Args args) {
    extern __shared__ __attribute__((aligned(16))) unsigned char lds[];
    LAS unsigned char* L = (LAS unsigned char*)lds;
    volatile LAS unsigned* MISC = (volatile LAS unsigned*)(L + MISC_OFF);
    const int tid = threadIdx.x, lane = tid & 63, wave = __builtin_amdgcn_readfirstlane(tid >> 6);
    const int G = gridDim.x, bx = blockIdx.x;
    const int vcu = (G % 8 == 0) ? (bx % 8) * (G / 8) + bx / 8 : bx;
#define ws (args.ws)
#define x_in (args.in[0])
#define attn_nw (args.in[1])
#define w_in (args.in[2])
#define gdn_cw (args.in[3])
#define a_log (args.in[4])
#define dt_bias (args.in[5])
#define gdn_nw (args.in[6])
#define cf_dw (args.in[7])
#define cf_db (args.in[8])
#define cf_lw (args.in[9])
#define cf_lb (args.in[10])
#define w_out (args.in[11])
#define ffn_nw (args.in[12])
#define w_router (args.in[13])
#define b_router (args.in[14])
#define wgu (args.in[15])
#define bgu (args.in[16])
#define wd (args.in[17])
#define bd (args.in[18])
#define final_nw (args.in[19])
#define hn ((bf16*)(ws + WS_HN))
#define xn8 ((unsigned char*)(ws + WS_HN))
#define proj ((bf16*)(ws + WS_PROJ))
#define beta ((float*)(ws + WS_BETA))
#define gl ((float*)(ws + WS_G))
#define mix ((bf16*)(ws + WS_MIX))
#define xmid ((bf16*)(ws + WS_XMID))
#define tope ((int*)(ws + WS_TOPE))
#define topg ((float*)(ws + WS_TOPG))
#define pos ((int*)(ws + WS_POS))
#define ghist ((int*)(ws + WS_HIST))
#define blke ((int*)(ws + WS_BLKE))
#define rgate ((float*)(ws + WS_RGATE))
#define wrh ((v4u*)(ws + WS_BLKE + 65536))
#define wrl ((v4u*)(ws + WS_BLKE + 131072))
#define xg ((unsigned char*)(ws + WS_XG))
#define hb ((unsigned char*)(ws + WS_HB))
#define yb ((bf16*)(ws + WS_Y))
#define winT ((bf16*)(ws + WS_WINT))
#define woutT ((bf16*)(ws + WS_WOUTT))
#define wguT ((unsigned char*)(ws + WS_WGUT))
#define wdT ((unsigned char*)(ws + WS_WDT))
#define Pf ((v4u*)(ws + WS_XG))
#define Qc ((v4u*)(ws + WS_XG + 32 * MiB))
#define RTf ((v4u*)(ws + WS_XG + 64 * MiB))
#define O0c ((f32x4*)(ws + WS_XG + 80 * MiB))
#define Sf ((v4u*)(ws + WS_XG + 112 * MiB))
#define out (args.out)

    for (int u = tid; u < (LDS_BYTES - LDSCTL_OFF) / 4; u += NWAVES * 64) ((LAS unsigned*)(L + LDSCTL_OFF))[u] = 0u;
    __syncthreads();
    const unsigned mask = args.mask;
    const bool multi = ((mask & 0xFFFu) & ((mask & 0xFFFu) - 1u)) != 0u;
    XcdBarrier bar; bar.bar = (unsigned*)(ws + WS_CTL) + CW_BAR + args.li * XCD_BAR_WORDS; bar.x = 0; bar.st = nullptr;
    if (multi) bar = xcd_barrier_post((unsigned*)(ws + WS_CTL) + CW_BAR + args.li * XCD_BAR_WORDS, MISC + 8);
#define IN(k) ((mask >> (k)) & 1u)
#define SEAM(k) do { if ((mask & 0xFFFu) >> ((k) + 1)) xcd_barrier(bar); } while (0)

    if (IN(PH_PRO)) {
        LAS float* scr = (LAS float*)(L + RING_OFF + wave * 16384);
        const int gw = vcu * NWAVES + wave, NGW = G * NWAVES;
        cv_run(gw, I_WIN, NGW, w_in, w_out, wgu, wd, winT, woutT, wguT, wdT, scr, lane);
        { const int gt = gw * 64 + lane;
          if (gt < 4096) { const int ks = gt >> 7, nt = (gt >> 6) & 1, r = gt & 15, q = (gt >> 4) & 3; unsigned hi[8], lo[8];
#pragma unroll
              for (int j = 0; j < 8; ++j) { const int k = 32 * ks + 8 * q + j; const float w = ffn_nw[k] * w_router[k * NE + 16 * nt + r]; hi[j] = f2bf(w); lo[j] = f2bf(w - bf2f(hi[j])); }
              v4u oh, ol; oh.x = hi[0] | (hi[1] << 16); oh.y = hi[2] | (hi[3] << 16); oh.z = hi[4] | (hi[5] << 16); oh.w = hi[6] | (hi[7] << 16);
              ol.x = lo[0] | (lo[1] << 16); ol.y = lo[2] | (lo[3] << 16); ol.z = lo[4] | (lo[5] << 16); ol.w = lo[6] | (lo[7] << 16);
              wrh[gt] = oh; wrl[gt] = ol; } }
        for (int t = gw * 4; t < T; t += NGW * 4) rms1_tokens<4>(t, lane, x_in, attn_nw, w_in, a_log, dt_bias, hn, beta, gl);
        SEAM(PH_PRO);
    }
    if (IN(PH_PROJ)) {
        pg8::Gemm g{hn, winT, T, PC, D}; pg8::StaticOrder S; S.init(T, PC, G, bx);
        pg8::EpiPlainBf16 E{proj, PC};
        pg8::gemm_phase<pg8::EpiPlainBf16, pg8::StaticOrder, true, true>(L + RING_OFF, g, S, E);
        SEAM(PH_PROJ);
    }
    if (IN(PH_CONF)) {
        for (int tile = bx; tile < T / 64; tile += G) conf_tile(tile, proj, cf_dw, cf_db, cf_lw, cf_lb, mix, (float*)(lds + RING_OFF));
        if (!IN(PH_GPREP)) SEAM(PH_CONF);
    }
    if (IN(PH_GPREP)) {
        for (int task = bx; task < 1024; task += G) gdn_prep_task(task, L, proj, gdn_cw, beta, gl, Pf, Qc, RTf, O0c);
        SEAM(PH_GPREP);
    }
    if (IN(PH_GCHAIN)) {
        if (bx < 64) {
            if (tid < 16) ((volatile LAS int*)(L + CH_FLAGS))[tid] = 0;
            __syncthreads();
            { if (wave == 0) gdn_chain_consumer(bx & 7, bx >> 3, lane, L, Sf, (unsigned*)(ws + WS_CTL) + CW_PROG + ((bx & 7) * 8 + (bx >> 3)) * 64); else if (wave < 7) gdn_chain_loader(wave - 1, bx & 7, bx >> 3, lane, L, Pf, Qc); }
        }
        else if (bx < 64 + NGOUT) {
            for (int p = bx - 64; p < 512; p += NGOUT) {
                const int n = p >> 2, bh0 = 2 * (p & 3);
                if (wave == 0) {
                    const unsigned* pw = (const unsigned*)(ws + WS_CTL) + CW_PROG + ((bh0 + ((lane >> 3) & 1)) * 8 + (lane & 7)) * 64;
                    unsigned sp = 0;
                    for (;;) { const unsigned v = __hip_atomic_load(pw, __ATOMIC_RELAXED, __HIP_MEMORY_SCOPE_AGENT); if (__all((lane >= 16) || (v >= (unsigned)(n + 1)))) break; __builtin_amdgcn_s_sleep(32); if (++sp > (1u << 20)) break; }
                    __builtin_amdgcn_fence(__ATOMIC_ACQUIRE, "agent");
                    asm volatile("s_waitcnt vmcnt(0)" ::: "memory");
                }
                __syncthreads();
                gdn_out_wave((bh0 + (wave >> 2)) * 128 + n, wave & 3, lane, Sf, RTf, O0c, proj, gdn_nw, mix);
                __syncthreads();
            }
        }
        else {
            {
                LAS float* scr = (LAS float*)(L + RING_OFF + wave * 16384);
                const int gw = (bx - 64 - NGOUT) * NWAVES + wave, NGW = (G - 64 - NGOUT) * NWAVES;
                cv_run(I_WIN + gw, I_ALL, NGW, w_in, w_out, wgu, wd, winT, woutT, wguT, wdT, scr, lane);
            }
        }
        SEAM(PH_GCHAIN);
    }
    if (IN(PH_OUT)) {
        pg8::Gemm g{mix, woutT, T, D, D}; pg8::StaticOrder S; S.init(T, D, G, bx);
        pg8::EpiResBf16 E{xmid, x_in, D};
        pg8::gemm_phase<pg8::EpiResBf16, pg8::StaticOrder, true, true>(L + RING_OFF, g, S, E);
        SEAM(PH_OUT);
    }
    if (IN(PH_RMS2)) {
        for (int grp = bx; grp < NWG; grp += G) rms2_group(grp, xmid, ffn_nw, wrh, wrl, b_router, xn8, tope, topg, ghist, lds + RING_OFF);
        SEAM(PH_RMS2);
    }
    if (IN(PH_ROUTE)) {
        for (int grp = bx; grp < NWG; grp += G) route_group(grp, ghist, tope, topg, xn8, pos, rgate, blke, xg, (int*)(lds + RING_OFF));
        SEAM(PH_ROUTE);
    }
    if (IN(PH_MOE1)) {
        pg8::Gemm g{(const pg8::bf16_t*)xg, (const pg8::bf16_t*)wguT, RPAD, 2048, D / 2}; pg8::MoeOrder S; S.init(blke, MAXBLK, 8, G, bx);
        pg8::EpiSwiglu E{hb, bgu};
        pg8::gemm_phase<pg8::EpiSwiglu, pg8::MoeOrder, true, true, 122, 127>(L + RING_OFF, g, S, E);
        SEAM(PH_MOE1);
    }
    if (IN(PH_MOE2)) {
        pg8::Gemm g{(const pg8::bf16_t*)hb, (const pg8::bf16_t*)wdT, RPAD, D, FF / 2}; pg8::MoeOrder S; S.init(blke, MAXBLK, 4, G, bx);
        pg8::EpiDown E{yb, bd, rgate};
        pg8::gemm_phase<pg8::EpiDown, pg8::MoeOrder, true, true, 122, 125>(L + RING_OFF, g, S, E);
        SEAM(PH_MOE2);
    }
    if (IN(PH_COMB)) {
        const int gw = vcu * NWAVES + wave, NGW = G * NWAVES;
        for (int t = gw; t < T; t += NGW) combine_token(t, lane, xmid, yb, pos, final_nw, out);
    }
#undef IN
#undef SEAM
#undef ws
#undef x_in
#undef attn_nw
#undef w_in
#undef gdn_cw
#undef a_log
#undef dt_bias
#undef gdn_nw
#undef cf_dw
#undef cf_db
#undef cf_lw
#undef cf_lb
#undef w_out
#undef ffn_nw
#undef w_router
#undef b_router
#undef wgu
#undef bgu
#undef wd
#undef bd
#undef final_nw
#undef hn
#undef proj
#undef beta
#undef gl
#undef mix
#undef xmid
#undef tope
#undef topg
#undef pos
#undef ghist
#undef blke
#undef rgate
#undef wrh
#undef wrl
#undef xg
#undef hb
#undef yb
#undef winT
#undef woutT
#undef wguT
#undef wdT
#undef Pf
#undef Qc
#undef RTf
#undef O0c
#undef Sf
#undef out
}

extern "C" void kernel_launch(void* const* d_in, const int* in_sizes, int n_in, void* d_out, int out_size, void* d_ws, size_t ws_size, hipStream_t stream) {
    static int grid = 0;
    if (grid == 0) {
        if (n_in != 20 || ws_size < WS_END) { fprintf(stderr, "kernel_launch: unexpected n_in %d / ws %zu (need %zu)\n", n_in, ws_size, (size_t)WS_END); grid = -1; return; }
        int dev = 0, cus = 0, per_cu = 0;
        if (hipGetDevice(&dev) != hipSuccess || hipDeviceGetAttribute(&cus, hipDeviceAttributeMultiprocessorCount, dev) != hipSuccess) { grid = -1; return; }
        if (hipFuncSetAttribute((const void*)mega, hipFuncAttributeMaxDynamicSharedMemorySize, LDS_BYTES) != hipSuccess) { fprintf(stderr, "kernel_launch: hipFuncSetAttribute failed\n"); grid = -1; return; }
        if (hipOccupancyMaxActiveBlocksPerMultiprocessor(&per_cu, (const void*)mega, NWAVES * 64, LDS_BYTES) != hipSuccess || per_cu < 1) { fprintf(stderr, "kernel_launch: occupancy query says %d\n", per_cu); }
        (void)hipGetLastError();
        grid = cus;
    }
    if (grid < 0) return;
    unsigned char* ws = (unsigned char*)d_ws;
    if (hipMemsetAsync(ws + WS_CTL, 0, 1 * MiB, stream) != hipSuccess) return;
    Args a{};
    for (int i = 0; i < 20; ++i) a.in[i] = (const float*)d_in[i];
    a.out = (float*)d_out; a.ws = ws;
    a.mask = 0xFFFu & ~(1u << PH_GOUT); a.li = 0;
    hipLaunchKernelGGL(mega, dim3(grid), dim3(NWAVES * 64), LDS_BYTES, stream, a);
}
```

```cpp
#include <hip/hip_runtime.h>
#include <cstdint>
#include <cstdio>
#include <type_traits>

namespace cfg {
constexpr int B = 2, S = 8192, T = B * S, D = 1024;
constexpr int H = 4, DK = 128, DV = 128, QK = 512;
constexpr int CF = 512, CFK = 31, NE = 32, TOPK = 4, FF = 1024;
constexpr int OFF_B = 2048, OFF_A = 2052, OFF_CF = 2056, IN_COLS = 3080;
constexpr int PC = 3072;
constexpr float EPS = 1e-6f;
constexpr int RB = 256;
constexpr int MAXBLK = 256 + 32;
constexpr int RPAD = MAXBLK * RB;
constexpr int NWG = 256;
}
using namespace cfg;

typedef unsigned short bf16;
__device__ __forceinline__ unsigned f2bf(float f) { unsigned u = __builtin_bit_cast(unsigned, f); return (u + 0x7fffu + ((u >> 16) & 1u)) >> 16; }
__device__ __forceinline__ float bf2f(unsigned h) { return __builtin_bit_cast(float, h << 16); }
__device__ __forceinline__ unsigned pk2(float lo, float hi) { return f2bf(lo) | (f2bf(hi) << 16); }
__device__ __forceinline__ float sigmoidf_(float x) { return __builtin_amdgcn_rcpf(1.f + __expf(-x)); }
__device__ __forceinline__ float siluf_(float x) { return x * sigmoidf_(x); }
__device__ __forceinline__ float softplusf_(float x) { return fmaxf(x, 0.f) + log1pf(__expf(-fabsf(x))); }
__device__ __forceinline__ float wave_sum(float v) {
    v += __builtin_bit_cast(float, __builtin_amdgcn_update_dpp(0, __builtin_bit_cast(int, v), 0x111, 0xf, 0xf, false));
    v += __builtin_bit_cast(float, __builtin_amdgcn_update_dpp(0, __builtin_bit_cast(int, v), 0x112, 0xf, 0xf, false));
    v += __builtin_bit_cast(float, __builtin_amdgcn_update_dpp(0, __builtin_bit_cast(int, v), 0x114, 0xf, 0xf, false));
    v += __builtin_bit_cast(float, __builtin_amdgcn_update_dpp(0, __builtin_bit_cast(int, v), 0x118, 0xf, 0xf, false));
    v += __builtin_bit_cast(float, __builtin_amdgcn_update_dpp(0, __builtin_bit_cast(int, v), 0x142, 0xa, 0xf, false));
    v += __builtin_bit_cast(float, __builtin_amdgcn_update_dpp(0, __builtin_bit_cast(int, v), 0x143, 0xc, 0xf, false));
    return __builtin_bit_cast(float, __builtin_amdgcn_readlane(__builtin_bit_cast(int, v), 63));
}

constexpr size_t MiB = 1u << 20;
constexpr size_t WS_CTL = 0;
constexpr size_t WS_HN = 1 * MiB;
constexpr size_t WS_PROJ = WS_HN + 32 * MiB;
constexpr size_t WS_BETA = WS_PROJ + 96 * MiB;
constexpr size_t WS_G = WS_BETA + 1 * MiB;
constexpr size_t WS_MIX = WS_G + 1 * MiB;
constexpr size_t WS_XMID = WS_MIX + 32 * MiB;
constexpr size_t WS_TOPE = WS_XMID + 64 * MiB;
constexpr size_t WS_TOPG = WS_TOPE + 1 * MiB;
constexpr size_t WS_POS = WS_TOPG + 1 * MiB;
constexpr size_t WS_HIST = WS_POS + 1 * MiB;
constexpr size_t WS_BLKE = WS_HIST + 1 * MiB;
constexpr size_t WS_RGATE = WS_BLKE + 1 * MiB;
constexpr size_t WS_XG = WS_RGATE + 1 * MiB;
constexpr size_t WS_HB = WS_XG + 144 * MiB;
constexpr size_t WS_Y = WS_HB + 144 * MiB;
constexpr size_t WS_WINT = WS_Y + 144 * MiB;
constexpr size_t WS_WOUTT = WS_WINT + 6 * MiB;
constexpr size_t WS_WGUT = WS_WOUTT + 2 * MiB;
constexpr size_t WS_WDT = WS_WGUT + 128 * MiB;
constexpr size_t WS_END = WS_WDT + 64 * MiB;


#define GAS __attribute__((address_space(1)))
#define LAS __attribute__((address_space(3)))
typedef unsigned v4u __attribute__((ext_vector_type(4)));
#define LDS_WAIT() asm volatile("s_waitcnt lgkmcnt(0)" ::: "memory")
#define VM_WAIT() asm volatile("s_waitcnt vmcnt(0)" ::: "memory")

namespace pg8 {
#define PG8_LAS __attribute__((address_space(3)))
typedef unsigned short bf16_t;
typedef short bf16x8 __attribute__((ext_vector_type(8)));
typedef float f32x4 __attribute__((ext_vector_type(4)));
typedef unsigned u32x4 __attribute__((ext_vector_type(4)));
constexpr int BM = 256, BK = 64, HALF = 128, HTB = HALF * BK * 2  , STAGE_BYTES = 8 * HTB, NXCD = 8, WGM = 8;

__host__ __device__ __forceinline__ int lds_byte(int r, int c) { const int st = (r >> 4) * 2 + (c >> 5), rr = r & 15, cc = c & 31, ob = rr * 64 + cc * 2; return st * 1024 + (ob ^ (((ob >> 9) & 1) << 5)); }
__host__ __device__ __forceinline__ void stage_rc(int b, int& R, int& C) { const int st = b / 1024, sb = b % 1024, swz = sb ^ (((sb >> 9) & 1) << 5); R = (st >> 1) * 16 + swz / 64; C = (st & 1) * 32 + (swz % 64) / 2; }
__host__ __device__ __forceinline__ int perm32(int rho) { const int n = rho >> 4, i = rho & 15; return 8 * (i >> 2) + 4 * n + (i & 3); }

struct Unit { int pm, pn, pb, e; };
struct Gemm { const bf16_t* A; const bf16_t* Bt; int M, N, K; };

struct StaticOrder {
    int nM, nN, nwg, G, c;
    __host__ __device__ void init(int M, int N, int G_, int c_) { nM = M / BM; nN = N / BM; nwg = nM * nN; G = G_; c = c_; }
    __host__ __device__ bool next(int i, Unit& u) const {
        const long L = (long)i * G + c; if (L >= nwg) return false;
        int wgid = (int)L; { const int q = nwg / NXCD, r = nwg % NXCD, xcd = wgid % NXCD, off = wgid / NXCD; wgid = (xcd < r ? xcd * (q + 1) : r * (q + 1) + (xcd - r) * q) + off; }
        const int nig = WGM * nN, gid = wgid / nig, fm = gid * WGM, gsz = (nM - fm) < WGM ? (nM - fm) : WGM;
        u.pm = fm + ((wgid % nig) % gsz); u.pn = (wgid % nig) / gsz; u.pb = u.pn; u.e = 0; return true;
    }
    __device__ __forceinline__ void a_ready(const Unit&) const {}
    __device__ __forceinline__ void done(const Unit&) const {}
};

__device__ __forceinline__ unsigned cvt_pk_bf16(float lo, float hi) { unsigned r; asm volatile("v_cvt_pk_bf16_f32 %0, %1, %2" : "=v"(r) : "v"(lo), "v"(hi)); return r; }
__device__ __forceinline__ int ld_i32_sc1(const int* p) { return (int)__hip_atomic_load((const unsigned*)p, __ATOMIC_RELAXED, __HIP_MEMORY_SCOPE_AGENT); }
struct MoeOrder {
    int nM, nN, nwg, G, c; const int* blke;
    __device__ void init(const int* blke_, int nblk_slot, int nN_, int G_, int c_) { blke = blke_; nM = ld_i32_sc1(blke_ + nblk_slot); nN = nN_; nwg = nM * nN; G = G_; c = c_; }
    __device__ bool next(int i, Unit& u) const {
        const long L = (long)i * G + c; if (L >= nwg) return false;
        int wgid = (int)L; { const int q = nwg / NXCD, r = nwg % NXCD, xcd = wgid % NXCD, off = wgid / NXCD; wgid = (xcd < r ? xcd * (q + 1) : r * (q + 1) + (xcd - r) * q) + off; }
        const int nig = WGM * nN, gid = wgid / nig, fm = gid * WGM, gsz = (nM - fm) < WGM ? (nM - fm) : WGM;
        u.pm = fm + ((wgid % nig) % gsz); u.pn = (wgid % nig) / gsz; u.e = ld_i32_sc1(blke + u.pm); u.pb = u.e * nN + u.pn; return true;
    }
    __device__ __forceinline__ void a_ready(const Unit&) const {}
    __device__ __forceinline__ void done(const Unit&) const {}
};
struct EpiResBf16 {
    static constexpr bool PERM = true, AFTER_DRAIN = false;
    bf16_t* O; const float* R; int ldc;
    __device__ __forceinline__ void operator()(const f32x4 (&acc)[2][2][4][2], const Unit& u, int wr, int wc, int fr, int fq) const {
        const int row0 = u.pm * BM + wr * 64 + fr, col0 = u.pn * BM + wc * 32 + 8 * fq;
#pragma unroll
        for (int ai = 0; ai < 2; ++ai)
#pragma unroll
            for (int m = 0; m < 4; ++m) { const size_t ro = (size_t)(row0 + ai * HALF + m * 16) * ldc + col0;
#pragma unroll
                for (int bj = 0; bj < 2; ++bj) { const f32x4 v0 = acc[ai][bj][m][0] + *(const f32x4*)(R + ro + bj * HALF), v1 = acc[ai][bj][m][1] + *(const f32x4*)(R + ro + bj * HALF + 4);
                    u32x4 w; w.x = cvt_pk_bf16(v0[0], v0[1]); w.y = cvt_pk_bf16(v0[2], v0[3]); w.z = cvt_pk_bf16(v1[0], v1[1]); w.w = cvt_pk_bf16(v1[2], v1[3]);
                    *(u32x4*)(O + ro + bj * HALF) = w; } }
    }
};
struct EpiSwiglu {
    static constexpr bool PERM = true, AFTER_DRAIN = false;
    unsigned char* O; const float* bgu;
    __device__ __forceinline__ void operator()(const f32x4 (&acc)[2][2][4][2], const Unit& u, int wr, int wc, int fr, int fq) const {
        const int row0 = u.pm * BM + wr * 64 + fr, colg = u.pn * HALF + wc * 32 + 8 * fq;
        const float* bg = bgu + (size_t)u.e * 2048 + colg;
        const f32x4 bgv[2] = {*(const f32x4*)bg, *(const f32x4*)(bg + 4)}, buv[2] = {*(const f32x4*)(bg + 1024), *(const f32x4*)(bg + 1028)};
#pragma unroll
        for (int ai = 0; ai < 2; ++ai)
#pragma unroll
            for (int m = 0; m < 4; ++m) { unsigned char* rowp = O + (size_t)(row0 + ai * HALF + m * 16) * 1024 + colg;
                float r[8];
#pragma unroll
                for (int n = 0; n < 2; ++n) { const f32x4 g = acc[ai][0][m][n] + bgv[n], uu = acc[ai][1][m][n] + buv[n];
#pragma unroll
                    for (int i = 0; i < 4; ++i) { const float gc = fminf(g[i], 7.f), uc = fminf(fmaxf(uu[i], -7.f), 7.f);
                        r[4 * n + i] = 4.f * (uc + 1.f) * gc * __builtin_amdgcn_rcpf(1.f + __expf(-1.702f * gc)); } }
                int w0 = 0, w1 = 0;
                w0 = __builtin_amdgcn_cvt_pk_fp8_f32(r[0], r[1], w0, false); w0 = __builtin_amdgcn_cvt_pk_fp8_f32(r[2], r[3], w0, true);
                w1 = __builtin_amdgcn_cvt_pk_fp8_f32(r[4], r[5], w1, false); w1 = __builtin_amdgcn_cvt_pk_fp8_f32(r[6], r[7], w1, true);
                typedef unsigned u32x2_ __attribute__((ext_vector_type(2)));
                *(u32x2_*)rowp = (u32x2_){(unsigned)w0, (unsigned)w1}; }
    }
};
struct EpiDown {
    static constexpr bool PERM = true, AFTER_DRAIN = false;
    unsigned char* O; const float* bd; const float* rgate;
    __device__ __forceinline__ void operator()(const f32x4 (&acc)[2][2][4][2], const Unit& u, int wr, int wc, int fr, int fq) const {
        const int row0 = u.pm * BM + wr * 64 + fr, col0 = u.pn * BM + wc * 32 + 8 * fq;
        const float* bp = bd + (size_t)u.e * 1024 + col0;
        f32x4 bv[2][2];
#pragma unroll
        for (int bj = 0; bj < 2; ++bj)
#pragma unroll
            for (int n = 0; n < 2; ++n) bv[bj][n] = *(const f32x4*)(bp + bj * HALF + 4 * n);
#pragma unroll
        for (int ai = 0; ai < 2; ++ai)
#pragma unroll
            for (int m = 0; m < 4; ++m) { const int row = row0 + ai * HALF + m * 16; const float sc = 16.f * __hip_atomic_load(rgate + row, __ATOMIC_RELAXED, __HIP_MEMORY_SCOPE_AGENT);
                unsigned char* rowp = O + (size_t)row * 1024 + col0;
#pragma unroll
                for (int bj = 0; bj < 2; ++bj) { const f32x4 v0 = (acc[ai][bj][m][0] + bv[bj][0]) * sc, v1 = (acc[ai][bj][m][1] + bv[bj][1]) * sc;
                    int w0 = 0, w1 = 0;
                    w0 = __builtin_amdgcn_cvt_pk_fp8_f32(v0[0], v0[1], w0, false); w0 = __builtin_amdgcn_cvt_pk_fp8_f32(v0[2], v0[3], w0, true);
                    w1 = __builtin_amdgcn_cvt_pk_fp8_f32(v1[0], v1[1], w1, false); w1 = __builtin_amdgcn_cvt_pk_fp8_f32(v1[2], v1[3], w1, true);
                    typedef unsigned u32x2_ __attribute__((ext_vector_type(2)));
                    *(u32x2_*)(rowp + bj * HALF) = (u32x2_){(unsigned)w0, (unsigned)w1}; } }
    }
};
struct EpiPlainBf16 {
    static constexpr bool PERM = true, AFTER_DRAIN = false;
    bf16_t* O; int ldc;
    __device__ __forceinline__ void operator()(const f32x4 (&acc)[2][2][4][2], const Unit& u, int wr, int wc, int fr, int fq) const {
        const int row0 = u.pm * BM + wr * 64 + fr, col0 = u.pn * BM + wc * 32 + 8 * fq;
#pragma unroll
        for (int ai = 0; ai < 2; ++ai)
#pragma unroll
            for (int m = 0; m < 4; ++m) { bf16_t* rowp = O + (size_t)(row0 + ai * HALF + m * 16) * ldc + col0;
#pragma unroll
                for (int bj = 0; bj < 2; ++bj) { const f32x4 v0 = acc[ai][bj][m][0], v1 = acc[ai][bj][m][1];
                    u32x4 w; w.x = cvt_pk_bf16(v0[0], v0[1]); w.y = cvt_pk_bf16(v0[2], v0[3]); w.z = cvt_pk_bf16(v1[0], v1[1]); w.w = cvt_pk_bf16(v1[2], v1[3]);
                    *(u32x4*)(rowp + bj * HALF) = w; } }
    }
};
template <class Epi, class Sched, bool ALIGN_EPI = false, bool SP2 = false, int F8W = 0, int F8A = 0>
__device__ __forceinline__ void gemm_phase(PG8_LAS unsigned char* lds, const Gemm g, const Sched& S, const Epi& E) {
    const int tid = threadIdx.x, wid = __builtin_amdgcn_readfirstlane(tid >> 6), lane = tid & 63, wr = wid >> 2, wc = wid & 3, fr = lane & 15, fq = lane >> 4;
    const int K = g.K, nt = K / BK;
    unsigned voffA[2], voffB[2];
#pragma unroll
    for (int i = 0; i < 2; ++i) { int R, C; stage_rc(tid * 16 + i * 8192, R, C); const int Rb = Epi::PERM ? ((R & ~31) + perm32(R & 31)) : R;
        voffA[i] = (unsigned)(R * K + C) * 2u; voffB[i] = (unsigned)(Rb * K + C) * 2u; }
    const size_t kstep = (size_t)(BK * 2);
    const size_t hstep = (size_t)HALF * K * 2;
    const size_t tstep = 2 * hstep;
    const unsigned ldsw = (unsigned)wid * 1024u;
    const int aoff = lds_byte(wr * 64 + fr, fq * 8), boff = lds_byte(wc * 32 + fr, fq * 8);
#define PG8_SA(b, h) (((b) * 2 + (h)) * HTB)
#define PG8_SB(b, h) ((4 + (b) * 2 + (h)) * HTB)
#define PG8_STAGE(bufoff, gbase, voff) do { _Pragma("unroll") for (int _i = 0; _i < 2; ++_i) \
        __builtin_amdgcn_global_load_lds((const unsigned*)((const char*)(gbase) + (voff)[_i]), (PG8_LAS unsigned*)(lds + (bufoff) + ldsw + _i * 8192), 16, 0, 0); } while (0)
#define PG8_LD1(dst, addr) do { if constexpr (F8W != 0) { (dst).v = __builtin_shufflevector(*(const PG8_LAS i32x4_*)(addr), *(const PG8_LAS i32x4_*)((addr) + 1024), 0, 1, 2, 3, 4, 5, 6, 7); } \
        else { (dst).v[0] = *(const PG8_LAS bf16x8*)(addr); (dst).v[1] = *(const PG8_LAS bf16x8*)((addr) + 1024); } } while (0)
#define PG8_LDA(dst, b, h) do { _Pragma("unroll") for (int m = 0; m < 4; ++m) PG8_LD1(dst[m], lds + PG8_SA(b, h) + aoff + m * 2048); } while (0)
#define PG8_LDB(dst, b, h) do { _Pragma("unroll") for (int n = 0; n < 2; ++n) PG8_LD1(dst[n], lds + PG8_SB(b, h) + boff + n * 2048); } while (0)
#define PG8_MMA(ai, bj, At, Bt) do { __builtin_amdgcn_s_setprio(1); _Pragma("unroll") for (int m = 0; m < 4; ++m) _Pragma("unroll") for (int n = 0; n < 2; ++n) { \
        if constexpr (F8W != 0) { asm volatile("v_mfma_scale_f32_16x16x128_f8f6f4 %0, %1, %2, %0, %3, %4 op_sel_hi:[0,0,0]" : "+v"(acc[ai][bj][m][n]) : "v"(Bt[n].v), "v"(At[m].v), "v"(f8sw), "v"(f8sa)); } \
        else { _Pragma("unroll") for (int k = 0; k < 2; ++k) acc[ai][bj][m][n] = __builtin_amdgcn_mfma_f32_16x16x32_bf16(Bt[n].v[k], At[m].v[k], acc[ai][bj][m][n], 0, 0, 0); } } \
        __builtin_amdgcn_s_setprio(0); } while (0)
#define PG8_WAIT_V(n) asm volatile("s_waitcnt vmcnt(" #n ")" ::: "memory")
#define PG8_WAIT_L(n) asm volatile("s_waitcnt lgkmcnt(" #n ")" ::: "memory")
#define PG8_BAR __builtin_amdgcn_s_barrier()
#define PG8_SCHED __builtin_amdgcn_sched_barrier(0)
    Unit cur, nxt; int ui = 0;
    if (!S.next(0, cur)) return;
    f32x4 acc[2][2][4][2];
#pragma unroll
    for (int a = 0; a < 2; ++a)
#pragma unroll
        for (int b = 0; b < 2; ++b)
#pragma unroll
            for (int m = 0; m < 4; ++m)
#pragma unroll
                for (int n = 0; n < 2; ++n) acc[a][b][m][n] = (f32x4){0.f, 0.f, 0.f, 0.f};
    typedef int i32x4_ __attribute__((ext_vector_type(4))); typedef int i32x8_ __attribute__((ext_vector_type(8)));
    struct FragBf { bf16x8 v[2]; }; struct FragF8 { i32x8_ v; };
    typedef typename std::conditional<F8W != 0, FragF8, FragBf>::type Frag;
    Frag At[4], B0[2], B1[2];
    const int f8sw = F8W, f8sa = F8A;
    const char* cA = (const char*)g.A + (size_t)cur.pm * tstep; const char* cB = (const char*)g.Bt + (size_t)cur.pb * tstep;
    S.a_ready(cur);
    if constexpr (SP2) {
        PG8_STAGE(PG8_SB(0, 0), cB, voffB); PG8_STAGE(PG8_SB(0, 1), cB + hstep, voffB); PG8_STAGE(PG8_SA(0, 0), cA, voffA); PG8_STAGE(PG8_SA(0, 1), cA + hstep, voffA);
        if (wr == 1) PG8_BAR;
        PG8_WAIT_V(2); PG8_BAR;
        PG8_STAGE(PG8_SB(1, 0), cB + kstep, voffB); PG8_STAGE(PG8_SA(1, 0), cA + kstep, voffA); PG8_STAGE(PG8_SB(1, 1), cB + hstep + kstep, voffB);
        PG8_WAIT_V(6); PG8_BAR;
    } else {
        PG8_STAGE(PG8_SB(0, 0), cB, voffB); PG8_STAGE(PG8_SA(0, 0), cA, voffA); PG8_STAGE(PG8_SB(0, 1), cB + hstep, voffB); PG8_STAGE(PG8_SA(0, 1), cA + hstep, voffA);
        if (wr == 1) PG8_BAR;
        PG8_WAIT_V(4); PG8_BAR;
        PG8_STAGE(PG8_SB(1, 0), cB + kstep, voffB); PG8_STAGE(PG8_SA(1, 0), cA + kstep, voffA); PG8_STAGE(PG8_SB(1, 1), cB + hstep + kstep, voffB);
        PG8_WAIT_V(6); PG8_BAR;
    }
    for (;;) {
        const bool has_next = S.next(ui + 1, nxt);
        const char* nA = has_next ? (const char*)g.A + (size_t)nxt.pm * tstep : cA; const char* nB = has_next ? (const char*)g.Bt + (size_t)nxt.pb * tstep : cB;
        for (int t = 0; t < nt; t += 2) {
            const bool last = (t == nt - 2);
            const char* a1 = cA + (size_t)(t + 1) * kstep;
            const char* a2 = last ? nA : cA + (size_t)(t + 2) * kstep; const char* b2 = last ? nB : cB + (size_t)(t + 2) * kstep;
            const char* a3 = a2 + kstep; const char* b3 = b2 + kstep;
            if (last && has_next) S.a_ready(nxt);
            if constexpr (SP2) {
            PG8_LDB(B0, 0, 0); PG8_LDB(B1, 0, 1); PG8_SCHED; PG8_LDA(At, 0, 0); PG8_STAGE(PG8_SA(1, 1), a1 + hstep, voffA);
            PG8_WAIT_V(8); PG8_WAIT_L(0); PG8_BAR; PG8_MMA(0, 0, At, B0); PG8_MMA(0, 1, At, B1); PG8_BAR; PG8_SCHED;
            PG8_LDA(At, 0, 1); PG8_STAGE(PG8_SB(0, 0), b2, voffB); PG8_STAGE(PG8_SB(0, 1), b2 + hstep, voffB); PG8_STAGE(PG8_SA(0, 0), a2, voffA);
            PG8_WAIT_V(8); PG8_WAIT_L(0); PG8_BAR; PG8_MMA(1, 0, At, B0); PG8_MMA(1, 1, At, B1); PG8_BAR; PG8_SCHED;
            PG8_LDB(B0, 1, 0); PG8_LDB(B1, 1, 1); PG8_SCHED; PG8_LDA(At, 1, 0); PG8_STAGE(PG8_SA(0, 1), a2 + hstep, voffA);
            PG8_WAIT_V(8); PG8_WAIT_L(0); PG8_BAR; PG8_MMA(0, 0, At, B0); PG8_MMA(0, 1, At, B1); PG8_BAR; PG8_SCHED;
            PG8_LDA(At, 1, 1); PG8_STAGE(PG8_SB(1, 0), b3, voffB); PG8_STAGE(PG8_SB(1, 1), b3 + hstep, voffB); PG8_STAGE(PG8_SA(1, 0), a3, voffA);
            PG8_WAIT_V(8); PG8_WAIT_L(0); PG8_BAR; PG8_MMA(1, 0, At, B0); PG8_MMA(1, 1, At, B1); PG8_BAR; PG8_SCHED;
            } else {
            PG8_LDB(B0, 0, 0); PG8_SCHED; PG8_LDA(At, 0, 0); PG8_STAGE(PG8_SA(1, 1), a1 + hstep, voffA);
            PG8_WAIT_L(8); PG8_BAR; PG8_WAIT_L(0); PG8_MMA(0, 0, At, B0); PG8_BAR; PG8_SCHED;
            PG8_LDB(B1, 0, 1); PG8_STAGE(PG8_SB(0, 0), b2, voffB);
            PG8_BAR; PG8_WAIT_L(0); PG8_MMA(0, 1, At, B1); PG8_BAR;
            PG8_LDA(At, 0, 1); PG8_STAGE(PG8_SA(0, 0), a2, voffA);
            PG8_BAR; PG8_WAIT_L(0); PG8_MMA(1, 0, At, B0); PG8_BAR; PG8_SCHED;
            PG8_STAGE(PG8_SB(0, 1), b2 + hstep, voffB);
            PG8_WAIT_V(6); PG8_BAR; PG8_MMA(1, 1, At, B1); PG8_BAR;
            PG8_LDB(B0, 1, 0); PG8_SCHED; PG8_LDA(At, 1, 0); PG8_STAGE(PG8_SA(0, 1), a2 + hstep, voffA);
            PG8_WAIT_L(8); PG8_BAR; PG8_WAIT_L(0); PG8_MMA(0, 0, At, B0); PG8_BAR; PG8_SCHED;
            PG8_LDB(B1, 1, 1); PG8_STAGE(PG8_SB(1, 0), b3, voffB);
            PG8_BAR; PG8_WAIT_L(0); PG8_MMA(0, 1, At, B1); PG8_BAR;
            PG8_LDA(At, 1, 1); PG8_STAGE(PG8_SA(1, 0), a3, voffA);
            PG8_BAR; PG8_WAIT_L(0); PG8_MMA(1, 0, At, B0); PG8_BAR; PG8_SCHED;
            PG8_STAGE(PG8_SB(1, 1), b3 + hstep, voffB);
            PG8_WAIT_V(6); PG8_BAR; PG8_MMA(1, 1, At, B1); PG8_BAR;
            }
        }
        if constexpr (F8W != 0) asm volatile("s_nop 15\n\ts_nop 15\n\ts_nop 15\n\ts_nop 15" ::: "memory");
        if constexpr (ALIGN_EPI) { if (wr == 0) PG8_BAR; }
        if constexpr (!Epi::AFTER_DRAIN) { E(acc, cur, wr, wc, fr, fq); S.done(cur); }
        if (!has_next) break;
#pragma unroll
        for (int a = 0; a < 2; ++a)
#pragma unroll
            for (int b = 0; b < 2; ++b)
#pragma unroll
                for (int m = 0; m < 4; ++m)
#pragma unroll
                    for (int n = 0; n < 2; ++n) acc[a][b][m][n] = (f32x4){0.f, 0.f, 0.f, 0.f};
        cur = nxt; cA = nA; cB = nB; ++ui;
        if constexpr (ALIGN_EPI) { if (wr == 1) PG8_BAR; }
    }
    PG8_WAIT_V(0);
    if constexpr (!ALIGN_EPI) { if (wr == 0) PG8_BAR; }
    PG8_BAR;
    if constexpr (Epi::AFTER_DRAIN) { E.fused(acc, cur, wr, wc, fr, fq, lds, wid, lane); S.done(cur); }
#undef PG8_SA
#undef PG8_SB
#undef PG8_STAGE
#undef PG8_LDA
#undef PG8_LD1
#undef PG8_LDB
#undef PG8_MMA
#undef PG8_WAIT_V
#undef PG8_WAIT_L
#undef PG8_BAR
#undef PG8_SCHED
}
}

#define XB_TMO      128
#define XB_XCNT(j)  (256  + 64 * (j))
#define XB_XSUB(j)  (1280 + 64 * (j))
#define XB_XGEN(j)  (2304 + 64 * (j))
#define XB_TOP      3328
#define XB_TOPGEN   3392
#define XCD_BAR_WORDS 3456
#define XB_SPIN_CAP (1u << 18)

__device__ __forceinline__ unsigned xb_ld(unsigned* p)              { return __hip_atomic_load(p, __ATOMIC_RELAXED, __HIP_MEMORY_SCOPE_AGENT); }
__device__ __forceinline__ unsigned xb_add(unsigned* p, unsigned v) { return __hip_atomic_fetch_add(p, v, __ATOMIC_RELAXED, __HIP_MEMORY_SCOPE_AGENT); }
__device__ __forceinline__ unsigned xb_xcc_id() { return (unsigned)__builtin_amdgcn_s_getreg((3 << 11) | 20) & 0xFu; }
#define XB_SPIN(cond, bar) do { unsigned _sp = 0; while (cond) { __builtin_amdgcn_s_sleep(1); \
    if ((++_sp & 255u) == 0u) { if (xb_ld(&(bar)[XB_TMO])) break; if (_sp > XB_SPIN_CAP) { atomicAdd(&(bar)[XB_TMO], 1u); break; } } } } while (0)

struct XcdBarrier {
    unsigned* bar; unsigned x;
    volatile LAS unsigned* st;
};

__device__ __forceinline__ XcdBarrier xcd_barrier_post(unsigned* bar, volatile LAS unsigned* st) {
    XcdBarrier b; b.bar = bar; b.x = xb_xcc_id(); b.st = st;
    if (threadIdx.x == 0) (void)xb_add(&bar[XB_XCNT(b.x)], 1u);
    return b;
}
__device__ __forceinline__ void xcd_barrier_complete(unsigned* bar, unsigned x, unsigned& nloc, unsigned& nx) {
    const unsigned G = gridDim.x * gridDim.y * gridDim.z;
    unsigned sum, cnt, mine, sp = 0u;
    for (;;) {
        sum = 0u; cnt = 0u; mine = 0u;
#pragma unroll
        for (unsigned j = 0; j < 16; ++j) { const unsigned c = xb_ld(&bar[XB_XCNT(j)]); sum += c; cnt += (c > 0u) ? 1u : 0u; mine = (j == x) ? c : mine; }
        if (sum == G) break;
        __builtin_amdgcn_s_sleep(1);
        if ((++sp & 255u) == 0u) { if (xb_ld(&bar[XB_TMO])) break; if (sp > XB_SPIN_CAP) { atomicAdd(&bar[XB_TMO], 1u); break; } }
    }
    nloc = mine > 0u ? mine : 1u; nx = cnt > 0u ? cnt : 1u;
}

__device__ __forceinline__ void xcd_barrier(const XcdBarrier& b) {
    asm volatile("s_waitcnt vmcnt(0)" ::: "memory");
    __syncthreads();
    if (threadIdx.x == 0) {
        unsigned* bar = b.bar;
        __builtin_amdgcn_s_waitcnt(0);
        unsigned nloc = b.st[0], nx = b.st[1];
        if (nloc == 0u) { xcd_barrier_complete(bar, b.x, nloc, nx); b.st[0] = nloc; b.st[1] = nx; }
        const unsigned old = xb_add(&bar[XB_XSUB(b.x)], 1u);
        const unsigned gen = old / nloc;
        if (old + 1u == (gen + 1u) * nloc) {
            __builtin_amdgcn_fence(__ATOMIC_RELEASE, "agent");
            asm volatile("s_waitcnt vmcnt(0)" ::: "memory");
            const unsigned og = xb_add(&bar[XB_TOP], 1u);
            const unsigned tg = og / nx;
            if (og + 1u == (tg + 1u) * nx) xb_add(&bar[XB_TOPGEN], 1u);
            else XB_SPIN(xb_ld(&bar[XB_TOPGEN]) == tg, bar);
            __builtin_amdgcn_fence(__ATOMIC_ACQUIRE, "agent");
            xb_add(&bar[XB_XGEN(b.x)], 1u);
            asm volatile("s_waitcnt vmcnt(0)" ::: "memory");
        } else {
            XB_SPIN(xb_ld(&bar[XB_XGEN(b.x)]) == gen, bar);
            __builtin_amdgcn_fence(__ATOMIC_ACQUIRE, "agent");
            asm volatile("s_waitcnt vmcnt(0)" ::: "memory");
        }
    }
    __syncthreads();
}

template <int NT>
__device__ __forceinline__ void rms1_tokens(int t0, int lane, const float* __restrict__ x, const float* __restrict__ nw, const float* __restrict__ w_in,
                                            const float* __restrict__ a_log, const float* __restrict__ dt_bias, bf16* hn, float* beta, float* gl) {
    float4 v[NT][4]; float rs[NT];
#pragma unroll
    for (int u = 0; u < NT; ++u) { const float4* xr = (const float4*)(x + (size_t)(t0 + u) * D); float ss = 0.f;
#pragma unroll
        for (int j = 0; j < 4; ++j) { v[u][j] = xr[lane + 64 * j]; ss += v[u][j].x * v[u][j].x + v[u][j].y * v[u][j].y + v[u][j].z * v[u][j].z + v[u][j].w * v[u][j].w; }
        rs[u] = ss; }
#pragma unroll
    for (int u = 0; u < NT; ++u) rs[u] = rsqrtf(wave_sum(rs[u]) * (1.f / D) + EPS);
    float dots[NT][8];
#pragma unroll
    for (int u = 0; u < NT; ++u)
#pragma unroll
        for (int c = 0; c < 8; ++c) dots[u][c] = 0.f;
#pragma unroll
    for (int j = 0; j < 4; ++j) {
        const int e = 4 * (lane + 64 * j);
        const float4 w = ((const float4*)nw)[lane + 64 * j];
        float h[NT][4];
#pragma unroll
        for (int u = 0; u < NT; ++u) { const float r = rs[u]; h[u][0] = v[u][j].x * r * w.x; h[u][1] = v[u][j].y * r * w.y; h[u][2] = v[u][j].z * r * w.z; h[u][3] = v[u][j].w * r * w.w;
            uint2 o; o.x = pk2(h[u][0], h[u][1]); o.y = pk2(h[u][2], h[u][3]);
            *(uint2*)(hn + (size_t)(t0 + u) * D + e) = o; }
#pragma unroll
        for (int i = 0; i < 4; ++i) {
            const float4* wr = (const float4*)(w_in + (size_t)(e + i) * IN_COLS + OFF_B);
            const float4 w0 = wr[0], w1 = wr[1];
#pragma unroll
            for (int u = 0; u < NT; ++u) { const float hh = h[u][i];
                dots[u][0] += hh * w0.x; dots[u][1] += hh * w0.y; dots[u][2] += hh * w0.z; dots[u][3] += hh * w0.w;
                dots[u][4] += hh * w1.x; dots[u][5] += hh * w1.y; dots[u][6] += hh * w1.z; dots[u][7] += hh * w1.w; }
        }
    }
#pragma unroll
    for (int u = 0; u < NT; ++u) {
#pragma unroll
        for (int c = 0; c < 8; ++c) dots[u][c] = wave_sum(dots[u][c]);
        if (lane < 4) {
            const float d = lane == 0 ? dots[u][0] : lane == 1 ? dots[u][1] : lane == 2 ? dots[u][2] : dots[u][3];
            beta[(t0 + u) * 4 + lane] = sigmoidf_(d);
            const float a = lane == 0 ? dots[u][4] : lane == 1 ? dots[u][5] : lane == 2 ? dots[u][6] : dots[u][7];
            gl[(t0 + u) * 4 + lane] = -__expf(a_log[lane]) * softplusf_(a + dt_bias[lane]);
        }
    }
}

__device__ __forceinline__ float conf_glu(const bf16* proj, int t, int c) {
    const float a = bf2f(proj[(size_t)t * PC + 2048 + c]), g = bf2f(proj[(size_t)t * PC + 2560 + c]);
    return a * sigmoidf_(g);
}
__device__ __forceinline__ void conf_tile(int tile, const bf16* proj, const float* __restrict__ dw, const float* __restrict__ db, const float* __restrict__ lw, const float* __restrict__ lb,
                                          bf16* mix, float* red  ) {
    const int c = threadIdx.x, wave = threadIdx.x >> 6, lane = threadIdx.x & 63;
    const int b = tile / (S / 64), s0 = (tile % (S / 64)) * 64, t0 = b * S + s0;
    float wj[CFK];
#pragma unroll
    for (int j = 0; j < CFK; ++j) wj[j] = dw[j * CF + c];
    const float bias = db[c], lnw = lw[c], lnb = lb[c];
    float win[38];
    unsigned short ra[8], rg[8];
#pragma unroll
    for (int i = 0; i < 8; ++i) { ra[i] = proj[(size_t)(t0 + i) * PC + 2048 + c]; rg[i] = proj[(size_t)(t0 + i) * PC + 2560 + c]; }
#pragma unroll
    for (int i = 0; i < 30; ++i) win[i] = (s0 - 30 + i >= 0) ? conf_glu(proj, t0 - 30 + i, c) : 0.f;
    for (int blk = 0; blk < 8; ++blk) {
#pragma unroll
        for (int i = 0; i < 8; ++i) win[30 + i] = bf2f(ra[i]) * sigmoidf_(bf2f(rg[i]));
        if (blk < 7) {
#pragma unroll
            for (int i = 0; i < 8; ++i) { ra[i] = proj[(size_t)(t0 + blk * 8 + 8 + i) * PC + 2048 + c]; rg[i] = proj[(size_t)(t0 + blk * 8 + 8 + i) * PC + 2560 + c]; }
        }
        float o[8];
#pragma unroll
        for (int i = 0; i < 8; ++i) { float a = bias;
#pragma unroll
            for (int j = 0; j < CFK; ++j) a += wj[j] * win[i + j];
            o[i] = a; }
        float* ob = red; float* st = red + 8 * CF;
#pragma unroll
        for (int i = 0; i < 8; ++i) ob[i * CF + c] = o[i];
        __syncthreads();
        { float s1 = 0.f, s2 = 0.f;
#pragma unroll
          for (int k = 0; k < 8; ++k) { const float v = ob[wave * CF + lane + 64 * k]; s1 += v; s2 += v * v; }
          s1 = wave_sum(s1); s2 = wave_sum(s2);
          if (lane == 0) { const float mu = s1 * (1.f / CF), var = fmaxf(s2 * (1.f / CF) - mu * mu, 0.f); st[2 * wave] = mu; st[2 * wave + 1] = rsqrtf(var + EPS); } }
        __syncthreads();
#pragma unroll
        for (int i = 0; i < 8; ++i) {
            const float y = (o[i] - st[2 * i]) * st[2 * i + 1] * lnw + lnb;
            mix[(size_t)(t0 + blk * 8 + i) * D + 512 + c] = (bf16)f2bf(siluf_(y));
        }
#pragma unroll
        for (int i = 0; i < 30; ++i) win[i] = win[i + 8];
    }
    __syncthreads();
}

typedef short bf16x8 __attribute__((ext_vector_type(8)));
typedef float f32x4 __attribute__((ext_vector_type(4)));
typedef unsigned u32x2 __attribute__((ext_vector_type(2)));
__device__ __forceinline__ f32x4 mfma16(bf16x8 a, bf16x8 b, f32x4 c) { return __builtin_amdgcn_mfma_f32_16x16x32_bf16(a, b, c, 0, 0, 0); }
__device__ __forceinline__ bf16x8 as_bf16x8(v4u v) { return __builtin_bit_cast(bf16x8, v); }
__device__ __forceinline__ void rms2_group(int grp, const bf16* xmid, const float* __restrict__ nw, const v4u* wrh, const v4u* wrl, const float* __restrict__ br, unsigned char* xn, int* tope, float* topg, int* ghist, unsigned char* sm) {
    float* rr = (float*)sm; float* lg = (float*)(sm + 256); int* lhist = (int*)(sm + 8704);
    const int tid = threadIdx.x, wave = __builtin_amdgcn_readfirstlane(tid >> 6), lane = tid & 63, tb = grp * 64;
    if (tid < NE) lhist[tid] = 0;
    {
        uint4 xa[8], xb[8];
#pragma unroll
        for (int i = 0; i < 8; ++i) { const uint4* xr = (const uint4*)(xmid + (size_t)(tb + 8 * wave + i) * D + 16 * lane); xa[i] = xr[0]; xb[i] = xr[1]; }
        float4 w4[4];
#pragma unroll
        for (int j = 0; j < 4; ++j) w4[j] = ((const float4*)(nw + 16 * lane))[j];
#pragma unroll
        for (int i = 0; i < 8; ++i) {
            const uint4 a = xa[i], b = xb[i];
            float v[16] = {bf2f(a.x & 0xffffu), bf2f(a.x >> 16), bf2f(a.y & 0xffffu), bf2f(a.y >> 16), bf2f(a.z & 0xffffu), bf2f(a.z >> 16), bf2f(a.w & 0xffffu), bf2f(a.w >> 16),
                           bf2f(b.x & 0xffffu), bf2f(b.x >> 16), bf2f(b.y & 0xffffu), bf2f(b.y >> 16), bf2f(b.z & 0xffffu), bf2f(b.z >> 16), bf2f(b.w & 0xffffu), bf2f(b.w >> 16)};
            float ss = 0.f;
#pragma unroll
            for (int j = 0; j < 16; ++j) ss += v[j] * v[j];
            const float r = rsqrtf(wave_sum(ss) * (1.f / D) + EPS);
            if (lane == 0) rr[8 * wave + i] = r;
            int o[4];
#pragma unroll
            for (int j = 0; j < 4; ++j) { const float4 w = w4[j];
                int p = 0; p = __builtin_amdgcn_cvt_pk_fp8_f32(v[4 * j] * r * w.x, v[4 * j + 1] * r * w.y, p, false); p = __builtin_amdgcn_cvt_pk_fp8_f32(v[4 * j + 2] * r * w.z, v[4 * j + 3] * r * w.w, p, true); o[j] = p; }
            *(int4*)(xn + (size_t)(tb + 8 * wave + i) * D + 16 * lane) = make_int4(o[0], o[1], o[2], o[3]);
        }
    }
    {
        const int r = lane & 15, q = lane >> 4, tt = wave >> 1, nt = wave & 1;
        const bf16* xrow = xmid + (size_t)(tb + 16 * tt + r) * D + 8 * q;
        f32x4 acc = (f32x4){0.f, 0.f, 0.f, 0.f};
#pragma unroll 1
        for (int k8 = 0; k8 < 32; k8 += 8) {
            v4u av[8], bh[8], bl[8];
#pragma unroll
            for (int u = 0; u < 8; ++u) { av[u] = *(const v4u*)(xrow + 32 * (k8 + u)); bh[u] = wrh[((k8 + u) * 2 + nt) * 64 + lane]; bl[u] = wrl[((k8 + u) * 2 + nt) * 64 + lane]; }
#pragma unroll
            for (int u = 0; u < 8; ++u) { acc = mfma16(as_bf16x8(av[u]), as_bf16x8(bh[u]), acc); acc = mfma16(as_bf16x8(av[u]), as_bf16x8(bl[u]), acc); }
        }
        __syncthreads();
        const float bb = br[16 * nt + r];
#pragma unroll
        for (int ii = 0; ii < 4; ++ii) { const int tok = 16 * tt + 4 * q + ii; lg[tok * 33 + 16 * nt + r] = acc[ii] * rr[tok] + bb; }
    }
    __syncthreads();
    if (tid < 64) {
        const float* l = lg + tid * 33;
        int ti[4]; float tv[4];
#pragma unroll
        for (int k = 0; k < 4; ++k) {
            float best = -INFINITY; int bi = 0;
            for (int x = 0; x < NE; ++x) { const bool taken = (k > 0 && ti[0] == x) || (k > 1 && ti[1] == x) || (k > 2 && ti[2] == x); const float v = l[x]; if (!taken && v > best) { best = v; bi = x; } }
            ti[k] = bi; tv[k] = best;
        }
        const float e1 = __expf(tv[1] - tv[0]), e2 = __expf(tv[2] - tv[0]), e3 = __expf(tv[3] - tv[0]);
        const float inv = 1.f / (1.f + e1 + e2 + e3);
        const int t = tb + tid;
        *(int4*)(tope + t * 4) = make_int4(ti[0], ti[1], ti[2], ti[3]);
        *(float4*)(topg + t * 4) = make_float4(inv, e1 * inv, e2 * inv, e3 * inv);
        atomicAdd(&lhist[ti[0]], 1); atomicAdd(&lhist[ti[1]], 1); atomicAdd(&lhist[ti[2]], 1); atomicAdd(&lhist[ti[3]], 1);
    }
    __syncthreads();
    if (tid < NE) ghist[grp * NE + tid] = lhist[tid];
    __syncthreads();
}

__device__ __forceinline__ void route_group(int grp, const int* ghist, const int* tope, const float* topg, const unsigned char* xn, int* pos, float* rgate, int* blke, unsigned char* xg, int* sm) {
    int* ptot = sm; int* ppre = sm + 512; int* tot = sm + 1024; int* pre = tot + 32; int* base = pre + 32; int* pe = base + 32; int* ppos = pe + 256;
    const int tid = threadIdx.x, nth = blockDim.x;
    if (tid < 256) pe[tid] = tope[grp * 256 + tid];
    { const int e = tid & 31, part = tid >> 5; int a = 0, p = 0;
#pragma unroll 4
      for (int w = part * 16; w < part * 16 + 16; ++w) { const int v = ghist[w * NE + e]; a += v; if (w < grp) p += v; }
      ptot[part * 32 + e] = a; ppre[part * 32 + e] = p; }
    __syncthreads();
    if (tid < NE) { int a = 0, p = 0;
#pragma unroll
        for (int part = 0; part < 16; ++part) { a += ptot[part * 32 + tid]; p += ppre[part * 32 + tid]; }
        tot[tid] = a; pre[tid] = p; }
    __syncthreads();
    if (tid == 0) {
        int blk = 0;
        for (int e = 0; e < NE; ++e) { base[e] = blk * RB; const int nb = (tot[e] + RB - 1) / RB; if (grp == 0) for (int q = 0; q < nb; ++q) blke[blk + q] = e; blk += nb; }
        if (grp == 0) blke[MAXBLK] = blk;
    }
    __syncthreads();
    if (tid < 256) {
        const int e = pe[tid]; int rank = 0;
        for (int p = 0; p < tid; ++p) rank += (pe[p] == e) ? 1 : 0;
        const int pp = base[e] + pre[e] + rank;
        ppos[tid] = pp; pos[grp * 256 + tid] = pp; rgate[pp] = topg[grp * 256 + tid];
    }
    __syncthreads();
    const int wave = tid >> 6, lane = tid & 63, nwave = nth >> 6;
    for (int p0 = wave * 8; p0 < 256; p0 += nwave * 8) {
        v4u v[8]; int dp[8];
#pragma unroll
        for (int u = 0; u < 8; ++u) { const int p = p0 + u; const int t = grp * 64 + (p >> 2); v[u] = ((const v4u*)(xn + (size_t)t * D))[lane]; dp[u] = ppos[p]; }
#pragma unroll
        for (int u = 0; u < 8; ++u) ((v4u*)(xg + (size_t)dp[u] * D))[lane] = v[u];
    }
    if (grp < NE) {
        const int e = grp, r0 = base[e] + tot[e], r1 = base[e] + ((tot[e] + RB - 1) / RB) * RB;
        for (int r = r0 + wave; r < r1; r += nwave) { uint4* dst = (uint4*)(xg + (size_t)r * D); dst[lane] = make_uint4(0, 0, 0, 0); if (lane == 0) rgate[r] = 0.f; }
    }
    __syncthreads();
}

__device__ __forceinline__ void combine_token(int t, int lane, const bf16* xmid, const unsigned char* y, const int* pos, const float* __restrict__ fw, float* out) {
    const uint2* xr = (const uint2*)(xmid + (size_t)t * D);
    const int4 pp = *(const int4*)(pos + t * 4);
    const int pr[4] = {pp.x, pp.y, pp.z, pp.w};
    float4 v[4]; float ss = 0.f;
#pragma unroll
    for (int j = 0; j < 4; ++j) {
        { const uint2 xx = xr[lane + 64 * j]; v[j] = make_float4(bf2f(xx.x & 0xffffu), bf2f(xx.x >> 16), bf2f(xx.y & 0xffffu), bf2f(xx.y >> 16)); }
#pragma unroll
        for (int k = 0; k < 4; ++k) { const int q = *(const int*)(y + (size_t)pr[k] * D + 4 * (lane + 64 * j));
            typedef float f32x2_ __attribute__((ext_vector_type(2)));
            const f32x2_ lo = __builtin_amdgcn_cvt_pk_f32_fp8(q, false), hi = __builtin_amdgcn_cvt_pk_f32_fp8(q, true);
            v[j].x += lo[0] * 0.0625f; v[j].y += lo[1] * 0.0625f; v[j].z += hi[0] * 0.0625f; v[j].w += hi[1] * 0.0625f; }
        ss += v[j].x * v[j].x + v[j].y * v[j].y + v[j].z * v[j].z + v[j].w * v[j].w;
    }
    const float r = rsqrtf(wave_sum(ss) * (1.f / D) + EPS);
#pragma unroll
    for (int j = 0; j < 4; ++j) { const float4 w = ((const float4*)fw)[lane + 64 * j];
        ((float4*)(out + (size_t)t * D))[lane + 64 * j] = make_float4(v[j].x * r * w.x, v[j].y * r * w.y, v[j].z * r * w.z, v[j].w * r * w.w); }
}

constexpr int GP_KN = 0, GP_QN = 17408, GP_VC = 34816, GP_AM = 52224, GP_IM = 69632, GP_UT = 78848, GP_WT = 97280, GP_KT = 115712, GP_GC = 134144, GP_BT = 134400, GP_TI = 134656, GP_END = 143872;
static_assert(GP_WT == GP_UT + 128 * 144, "uT and wT must be contiguous");
constexpr int AMS = 68;
constexpr int RS = 272, TS = 144;

__device__ __forceinline__ void gdn_prep_task(int task, LAS unsigned char* L, const bf16* proj, const float* __restrict__ cw, const float* beta, const float* gl,
                                              v4u* Pf, v4u* Qc, v4u* RTf, f32x4* O0c) {
    const int tid = threadIdx.x, lane = tid & 63, wave = __builtin_amdgcn_readfirstlane(tid >> 6), r = lane & 15, q = lane >> 4;
    const int bh = task >> 7, n = task & 127, b = bh >> 2, h = bh & 3, s0 = n * 64, t0 = b * S + s0;
    LAS float* gcs = (LAS float*)(L + GP_GC); LAS float* bts = (LAS float*)(L + GP_BT);
    {
        float g = gl[(t0 + lane) * 4 + h];
#pragma unroll
        for (int o = 1; o < 64; o <<= 1) { const float v = __shfl_up(g, o); if (lane >= o) g += v; }
        const float bt = beta[(t0 + lane) * 4 + h];
        if (wave == 0) { gcs[lane] = g; bts[lane] = bt; }
        const int i0 = 8 * wave, cb = h * 128 + 2 * lane;
        float wq[4][2], wk[4][2], wv[4][2];
#pragma unroll
        for (int j = 0; j < 4; ++j) { const float2 a = *(const float2*)(cw + j * 1536 + cb), bb = *(const float2*)(cw + j * 1536 + 512 + cb), c = *(const float2*)(cw + j * 1536 + 1024 + cb);
            wq[j][0] = a.x; wq[j][1] = a.y; wk[j][0] = bb.x; wk[j][1] = bb.y; wv[j][0] = c.x; wv[j][1] = c.y; }
        unsigned rq[11], rk[11], rv[11];
#pragma unroll
        for (int rho = 0; rho < 11; ++rho) {
            const int s = s0 + i0 - 3 + rho;
            if (s >= 0) { const bf16* p = proj + (size_t)(t0 + i0 - 3 + rho) * PC + cb; rq[rho] = *(const unsigned*)p; rk[rho] = *(const unsigned*)(p + 512); rv[rho] = *(const unsigned*)(p + 1024); }
            else { rq[rho] = 0u; rk[rho] = 0u; rv[rho] = 0u; }
        }
#pragma unroll
        for (int ii = 0; ii < 8; ++ii) {
            float q0 = 0.f, q1 = 0.f, k0 = 0.f, k1 = 0.f, v0 = 0.f, v1 = 0.f;
#pragma unroll
            for (int j = 0; j < 4; ++j) {
                q0 += wq[j][0] * bf2f(rq[ii + j] & 0xffffu); q1 += wq[j][1] * bf2f(rq[ii + j] >> 16);
                k0 += wk[j][0] * bf2f(rk[ii + j] & 0xffffu); k1 += wk[j][1] * bf2f(rk[ii + j] >> 16);
                v0 += wv[j][0] * bf2f(rv[ii + j] & 0xffffu); v1 += wv[j][1] * bf2f(rv[ii + j] >> 16);
            }
            q0 = siluf_(q0); q1 = siluf_(q1); k0 = siluf_(k0); k1 = siluf_(k1); v0 = siluf_(v0); v1 = siluf_(v1);
            const float sq = rsqrtf(wave_sum(q0 * q0 + q1 * q1) + EPS) * 0.08838834764831845f, sk = rsqrtf(wave_sum(k0 * k0 + k1 * k1) + EPS);
            const int ro = (i0 + ii) * RS + 4 * lane;
            *(LAS unsigned*)(L + GP_QN + ro) = pk2(q0 * sq, q1 * sq);
            *(LAS unsigned*)(L + GP_KN + ro) = pk2(k0 * sk, k1 * sk);
            *(LAS unsigned*)(L + GP_VC + ro) = pk2(v0, v1);
        }
    }
    __syncthreads();
    {
        const int ti = wave >> 1, tj0 = (wave & 1) * 2;
        f32x4 kk[2], qk[2];
#pragma unroll
        for (int u = 0; u < 2; ++u) { kk[u] = (f32x4){0.f, 0.f, 0.f, 0.f}; qk[u] = (f32x4){0.f, 0.f, 0.f, 0.f}; }
#pragma unroll
        for (int s = 0; s < 4; ++s) {
            const int co = (32 * s + 8 * q) * 2;
            const bf16x8 ak = *(const LAS bf16x8*)(L + GP_KN + (16 * ti + r) * RS + co), aq = *(const LAS bf16x8*)(L + GP_QN + (16 * ti + r) * RS + co);
#pragma unroll
            for (int u = 0; u < 2; ++u) { const bf16x8 bk = *(const LAS bf16x8*)(L + GP_KN + (16 * (tj0 + u) + r) * RS + co); kk[u] = mfma16(ak, bk, kk[u]); qk[u] = mfma16(aq, bk, qk[u]); }
        }
#pragma unroll
        for (int u = 0; u < 2; ++u) {
            const int j = 16 * (tj0 + u) + r; const float gcj = gcs[j];
#pragma unroll
            for (int ii = 0; ii < 4; ++ii) {
                const int i = 16 * ti + 4 * q + ii; const float gci = gcs[i], bti = bts[i];
                const float dec = (i >= j) ? __expf(gci - gcj) : 0.f;
                *(LAS float*)(L + GP_AM + (i * AMS + j) * 4) = (i > j) ? bti * kk[u][ii] * dec : 0.f;
                *(LAS unsigned short*)(L + GP_IM + i * TS + j * 2) = (unsigned short)f2bf(qk[u][ii] * dec);
            }
        }
    }
    __syncthreads();
    {
        float Ac[64];
#pragma unroll
        for (int j4 = 0; j4 < 64; j4 += 4) { const f32x4 av = *(const LAS f32x4*)(L + GP_AM + (lane * AMS + j4) * 4); Ac[j4] = av[0]; Ac[j4 + 1] = av[1]; Ac[j4 + 2] = av[2]; Ac[j4 + 3] = av[3]; }
        const float bti = bts[lane], gci = gcs[lane], ekt = __expf(gcs[63] - gci), ew = bti * __expf(gci);
        const int ca = 4 * wave, cb2 = 60 - 4 * wave;
        float xa[4], xb[4];
#pragma unroll
        for (int c = 0; c < 4; ++c) { xa[c] = (lane == ca + c) ? 1.f : 0.f; xb[c] = (lane == cb2 + c) ? 1.f : 0.f; }
#pragma unroll
        for (int jc = 0; jc < 8; ++jc) {
            if (8 * jc + 7 >= ca) {
#pragma unroll
                for (int jj = 0; jj < 8; ++jj) { const int j = 8 * jc + jj; if (j < 63) {
#pragma unroll
                    for (int c = 0; c < 4; ++c) { const float xj = __builtin_bit_cast(float, __builtin_amdgcn_readlane(__builtin_bit_cast(int, xa[c]), j)); xa[c] -= Ac[j] * xj; } } }
            }
            if (8 * jc + 7 >= cb2) {
#pragma unroll
                for (int jj = 0; jj < 8; ++jj) { const int j = 8 * jc + jj; if (j < 63) {
#pragma unroll
                    for (int c = 0; c < 4; ++c) { const float xj = __builtin_bit_cast(float, __builtin_amdgcn_readlane(__builtin_bit_cast(int, xb[c]), j)); xb[c] -= Ac[j] * xj; } } }
            }
        }
        { u32x2 o; o.x = pk2(xa[0], xa[1]); o.y = pk2(xa[2], xa[3]); *(LAS u32x2*)(L + GP_TI + lane * TS + ca * 2) = o;
          o.x = pk2(xb[0], xb[1]); o.y = pk2(xb[2], xb[3]); *(LAS u32x2*)(L + GP_TI + lane * TS + cb2 * 2) = o; }
#pragma unroll 1
        for (int gi = 0; gi < 4; ++gi) {
            const int cg = wave * 4 + gi, col0 = 8 * cg;
            const bool isw = col0 >= 128; const int cc = isw ? col0 - 128 : col0;
            const v4u raw = *(const LAS v4u*)(L + (isw ? GP_KN : GP_VC) + lane * RS + cc * 2);
            const float sc = isw ? ew : bti;
            const float x[8] = {bf2f(raw.x & 0xffffu) * sc, bf2f(raw.x >> 16) * sc, bf2f(raw.y & 0xffffu) * sc, bf2f(raw.y >> 16) * sc,
                                bf2f(raw.z & 0xffffu) * sc, bf2f(raw.z >> 16) * sc, bf2f(raw.w & 0xffffu) * sc, bf2f(raw.w >> 16) * sc};
            LAS unsigned char* dst = L + (isw ? GP_WT : GP_UT) + cc * TS + lane * 2;
#pragma unroll
            for (int c = 0; c < 8; ++c) *(LAS unsigned short*)(dst + c * TS) = (unsigned short)f2bf(x[c]);
        }
#pragma unroll 1
        for (int gi = 0; gi < 2; ++gi) {
            const int d0 = 8 * (wave * 2 + gi);
            const v4u raw = *(const LAS v4u*)(L + GP_KN + lane * RS + d0 * 2);
            const float x[8] = {bf2f(raw.x & 0xffffu) * ekt, bf2f(raw.x >> 16) * ekt, bf2f(raw.y & 0xffffu) * ekt, bf2f(raw.y >> 16) * ekt,
                                bf2f(raw.z & 0xffffu) * ekt, bf2f(raw.z >> 16) * ekt, bf2f(raw.w & 0xffffu) * ekt, bf2f(raw.w >> 16) * ekt};
            LAS unsigned char* dst = L + GP_KT + d0 * TS + lane * 2;
#pragma unroll
            for (int c = 0; c < 8; ++c) *(LAS unsigned short*)(dst + c * TS) = (unsigned short)f2bf(x[c]);
        }
    }
    __syncthreads();
    {
        const int co0 = (8 * q) * 2, co1 = (32 + 8 * q) * 2;
        bf16x8 tb0[4], tb1[4];
#pragma unroll
        for (int tn = 0; tn < 4; ++tn) { tb0[tn] = *(const LAS bf16x8*)(L + GP_TI + (16 * tn + r) * TS + co0); tb1[tn] = *(const LAS bf16x8*)(L + GP_TI + (16 * tn + r) * TS + co1); }
#pragma unroll
        for (int u = 0; u < 2; ++u) {
            LAS unsigned char* rows = L + GP_UT + (16 * (2 * wave + u)) * TS;
            const bf16x8 a0 = *(const LAS bf16x8*)(rows + r * TS + co0), a1 = *(const LAS bf16x8*)(rows + r * TS + co1);
            f32x4 cc[4];
#pragma unroll
            for (int tn = 0; tn < 4; ++tn) { cc[tn] = (f32x4){0.f, 0.f, 0.f, 0.f}; cc[tn] = mfma16(a0, tb0[tn], cc[tn]); cc[tn] = mfma16(a1, tb1[tn], cc[tn]); }
#pragma unroll
            for (int tn = 0; tn < 4; ++tn)
#pragma unroll
                for (int ii = 0; ii < 4; ++ii) *(LAS unsigned short*)(rows + (4 * q + ii) * TS + (16 * tn + r) * 2) = (unsigned short)f2bf(cc[tn][ii]);
        }
    }
    __syncthreads();
    {
        const float gtot = __expf(gcs[63]);
        const int co0 = (8 * q) * 2, co1 = (32 + 8 * q) * 2;
        {
            const bf16x8 b0 = *(const LAS bf16x8*)(L + GP_KT + (16 * wave + r) * TS + co0), b1 = *(const LAS bf16x8*)(L + GP_KT + (16 * wave + r) * TS + co1);
#pragma unroll
            for (int s = 0; s < 4; ++s) {
                const LAS unsigned char* a0p = L + GP_WT + (32 * s + r) * TS; const LAS unsigned char* a1p = a0p + 16 * TS;
                f32x4 c0 = (f32x4){0.f, 0.f, 0.f, 0.f}, c1 = c0;
                c0 = mfma16(*(const LAS bf16x8*)(a0p + co0), b0, c0); c0 = mfma16(*(const LAS bf16x8*)(a0p + co1), b1, c0);
                c1 = mfma16(*(const LAS bf16x8*)(a1p + co0), b0, c1); c1 = mfma16(*(const LAS bf16x8*)(a1p + co1), b1, c1);
                float v0[4], v1[4];
#pragma unroll
                for (int ii = 0; ii < 4; ++ii) { v0[ii] = ((2 * s == wave && 4 * q + ii == r) ? gtot : 0.f) - c0[ii]; v1[ii] = ((2 * s + 1 == wave && 4 * q + ii == r) ? gtot : 0.f) - c1[ii]; }
                v4u o; o.x = pk2(v0[0], v0[1]); o.y = pk2(v0[2], v0[3]); o.z = pk2(v1[0], v1[1]); o.w = pk2(v1[2], v1[3]);
                Pf[((size_t)(task * 8 + wave) * 4 + s) * 64 + lane] = o;
            }
        }
        {
            const bf16x8 b0 = *(const LAS bf16x8*)(L + GP_UT + (16 * wave + r) * TS + co0), b1 = *(const LAS bf16x8*)(L + GP_UT + (16 * wave + r) * TS + co1);
#pragma unroll
            for (int tp = 0; tp < 4; ++tp) {
                const LAS unsigned char* ap = L + GP_KT + (32 * tp + r) * TS; const LAS unsigned char* ap2 = ap + 16 * TS;
                f32x4 c = (f32x4){0.f, 0.f, 0.f, 0.f}, c2 = c;
                c = mfma16(*(const LAS bf16x8*)(ap + co0), b0, c); c = mfma16(*(const LAS bf16x8*)(ap + co1), b1, c);
                c2 = mfma16(*(const LAS bf16x8*)(ap2 + co0), b0, c2); c2 = mfma16(*(const LAS bf16x8*)(ap2 + co1), b1, c2);
                v4u o; o.x = pk2(c[0], c[1]); o.y = pk2(c[2], c[3]); o.z = pk2(c2[0], c2[1]); o.w = pk2(c2[2], c2[3]);
                Qc[((size_t)(task * 8 + wave) * 4 + tp) * 64 + lane] = o;
            }
        }
        {
            const int tn = wave & 3, i = 16 * tn + r; const float egi = __expf(gcs[i]);
            const bf16x8 b0 = *(const LAS bf16x8*)(L + GP_IM + i * TS + co0), b1 = *(const LAS bf16x8*)(L + GP_IM + i * TS + co1);
#pragma unroll
            for (int sx = 0; sx < 2; ++sx) {
                const int s = 2 * (wave >> 2) + sx;
                const LAS unsigned char* a0p = L + GP_WT + (32 * s + r) * TS; const LAS unsigned char* a1p = a0p + 16 * TS;
                f32x4 c0 = (f32x4){0.f, 0.f, 0.f, 0.f}, c1 = c0;
                c0 = mfma16(*(const LAS bf16x8*)(a0p + co0), b0, c0); c0 = mfma16(*(const LAS bf16x8*)(a0p + co1), b1, c0);
                c1 = mfma16(*(const LAS bf16x8*)(a1p + co0), b0, c1); c1 = mfma16(*(const LAS bf16x8*)(a1p + co1), b1, c1);
                const u32x2 q0 = *(const LAS u32x2*)(L + GP_QN + i * RS + (32 * s + 4 * q) * 2), q1 = *(const LAS u32x2*)(L + GP_QN + i * RS + (32 * s + 16 + 4 * q) * 2);
                v4u o;
                o.x = pk2(bf2f(q0.x & 0xffffu) * egi - c0[0], bf2f(q0.x >> 16) * egi - c0[1]); o.y = pk2(bf2f(q0.y & 0xffffu) * egi - c0[2], bf2f(q0.y >> 16) * egi - c0[3]);
                o.z = pk2(bf2f(q1.x & 0xffffu) * egi - c1[0], bf2f(q1.x >> 16) * egi - c1[1]); o.w = pk2(bf2f(q1.y & 0xffffu) * egi - c1[2], bf2f(q1.y >> 16) * egi - c1[3]);
                RTf[((size_t)(task * 4 + tn) * 4 + s) * 64 + lane] = o;
            }
        }
        {
            const bf16x8 a0 = *(const LAS bf16x8*)(L + GP_UT + (16 * wave + r) * TS + co0), a1 = *(const LAS bf16x8*)(L + GP_UT + (16 * wave + r) * TS + co1);
#pragma unroll
            for (int tn = 0; tn < 4; ++tn) {
                const LAS unsigned char* bp = L + GP_IM + (16 * tn + r) * TS;
                f32x4 c = (f32x4){0.f, 0.f, 0.f, 0.f};
                c = mfma16(a0, *(const LAS bf16x8*)(bp + co0), c); c = mfma16(a1, *(const LAS bf16x8*)(bp + co1), c);
                O0c[((size_t)(task * 8 + wave) * 4 + tn) * 64 + lane] = c;
            }
        }
    }
    __syncthreads();
}

constexpr int CH_SLOT = 36864, CH_FLAGS = 3 * CH_SLOT;
__device__ __forceinline__ void ch_spin(volatile LAS int* w, int want) {
    unsigned sp = 0; while (*w < want) { __builtin_amdgcn_s_sleep(1); if (++sp > (1u << 22)) break; }
    asm volatile("" ::: "memory");
}
__device__ __forceinline__ void gdn_chain_loader(int lw, int bh, int c, int lane, LAS unsigned char* L, const v4u* Pf, const v4u* Qc) {
    volatile LAS int* FL = (volatile LAS int*)(L + CH_FLAGS);
    const int sl = lw >> 1, hf = lw & 1;
    LAS unsigned char* slot = L + sl * CH_SLOT;
    for (int m = sl; m < 128; m += 3) {
        if (m >= 3) ch_spin(FL + 8 + sl, m - 2);
        const int task = bh * 128 + m;
        const v4u* ps = Pf + (size_t)task * 2048 + hf * 1024 + lane; const v4u* qs = Qc + (size_t)(task * 8 + c) * 256 + hf * 128 + lane;
#pragma unroll
        for (int f = 0; f < 16; ++f) __builtin_amdgcn_global_load_lds((const unsigned*)(ps + f * 64), (LAS unsigned*)(slot + (16 * hf + f) * 1024), 16, 0, 0);
#pragma unroll
        for (int f = 0; f < 2; ++f) __builtin_amdgcn_global_load_lds((const unsigned*)(qs + f * 64), (LAS unsigned*)(slot + 32768 + (2 * hf + f) * 1024), 16, 0, 0);
        asm volatile("s_waitcnt vmcnt(0)" ::: "memory");
        if (lane == 0) FL[lw] = m + 1;
    }
}
__device__ __forceinline__ unsigned cvtpk(float lo, float hi) { unsigned r; asm volatile("v_cvt_pk_bf16_f32 %0, %1, %2" : "=v"(r) : "v"(lo), "v"(hi)); return r; }
__device__ __forceinline__ void gdn_chain_consumer(int bh, int c, int lane, LAS unsigned char* L, v4u* Sf_, unsigned* prog) {
    volatile LAS int* FL = (volatile LAS int*)(L + CH_FLAGS);
    const __amdgpu_buffer_rsrc_t srs = __builtin_amdgcn_make_buffer_rsrc((void*)Sf_, (short)0, 32 << 20, 0x00020000);
    f32x4 acc[8];
#pragma unroll
    for (int t = 0; t < 8; ++t) acc[t] = (f32x4){0.f, 0.f, 0.f, 0.f};
    int sl = 0;
    for (int n = 0; n < 128; ++n) {
        const int task = bh * 128 + n;
        v4u sf[4];
#pragma unroll
        for (int s = 0; s < 4; ++s) { sf[s].x = cvtpk(acc[2 * s][0], acc[2 * s][1]); sf[s].y = cvtpk(acc[2 * s][2], acc[2 * s][3]); sf[s].z = cvtpk(acc[2 * s + 1][0], acc[2 * s + 1][1]); sf[s].w = cvtpk(acc[2 * s + 1][2], acc[2 * s + 1][3]);
            __builtin_amdgcn_raw_buffer_store_b128(sf[s], srs, (int)((((task * 8 + c) * 4 + s) * 64 + lane) * 16), 0, 16); }
        if (n == 127) break;
        ch_spin(FL + 2 * sl, n + 1); ch_spin(FL + 2 * sl + 1, n + 1);
        const LAS unsigned char* slot = L + sl * CH_SLOT + lane * 16;
        v4u qa, pa[8], qb, pb[8];
        qa = *(const LAS v4u*)(slot + 32768);
#pragma unroll
        for (int f = 0; f < 8; ++f) pa[f] = *(const LAS v4u*)(slot + f * 1024);
#pragma unroll
        for (int tp = 0; tp < 4; tp += 2) {
            qb = *(const LAS v4u*)(slot + 32768 + (tp + 1) * 1024);
#pragma unroll
            for (int f = 0; f < 8; ++f) pb[f] = *(const LAS v4u*)(slot + (8 * (tp + 1) + f) * 1024);
            __builtin_amdgcn_sched_barrier(0);
            { f32x4 a0 = (f32x4){bf2f(qa.x & 0xffffu), bf2f(qa.x >> 16), bf2f(qa.y & 0xffffu), bf2f(qa.y >> 16)}, a1 = (f32x4){bf2f(qa.z & 0xffffu), bf2f(qa.z >> 16), bf2f(qa.w & 0xffffu), bf2f(qa.w >> 16)};
#pragma unroll
              for (int s = 0; s < 4; ++s) { a0 = mfma16(as_bf16x8(pa[s]), as_bf16x8(sf[s]), a0); a1 = mfma16(as_bf16x8(pa[4 + s]), as_bf16x8(sf[s]), a1); }
              acc[2 * tp] = a0; acc[2 * tp + 1] = a1; }
            __builtin_amdgcn_sched_barrier(0);
            if (tp + 2 < 4) { qa = *(const LAS v4u*)(slot + 32768 + (tp + 2) * 1024);
#pragma unroll
                for (int f = 0; f < 8; ++f) pa[f] = *(const LAS v4u*)(slot + (8 * (tp + 2) + f) * 1024); }
            __builtin_amdgcn_sched_barrier(0);
            { f32x4 a0 = (f32x4){bf2f(qb.x & 0xffffu), bf2f(qb.x >> 16), bf2f(qb.y & 0xffffu), bf2f(qb.y >> 16)}, a1 = (f32x4){bf2f(qb.z & 0xffffu), bf2f(qb.z >> 16), bf2f(qb.w & 0xffffu), bf2f(qb.w >> 16)};
#pragma unroll
              for (int s = 0; s < 4; ++s) { a0 = mfma16(as_bf16x8(pb[s]), as_bf16x8(sf[s]), a0); a1 = mfma16(as_bf16x8(pb[4 + s]), as_bf16x8(sf[s]), a1); }
              acc[2 * tp + 2] = a0; acc[2 * tp + 3] = a1; }
            __builtin_amdgcn_sched_barrier(0);
        }
        asm volatile("s_waitcnt vmcnt(4) lgkmcnt(0)" ::: "memory");
        if (lane == 0) { FL[8 + sl] = n + 1; __hip_atomic_store(prog, (unsigned)n, __ATOMIC_RELAXED, __HIP_MEMORY_SCOPE_AGENT); }
        sl = (sl == 2) ? 0 : sl + 1;
    }
    asm volatile("s_waitcnt vmcnt(0)" ::: "memory");
    if (lane == 0) __hip_atomic_store(prog, 128u, __ATOMIC_RELAXED, __HIP_MEMORY_SCOPE_AGENT);
}

__device__ __forceinline__ void gdn_out_wave(int task, int tn, int lane, const v4u* Sf, const v4u* RTf, const f32x4* O0c, const bf16* proj, const float* __restrict__ nw, bf16* mix) {
    const int r = lane & 15, q = lane >> 4, bh = task >> 7, n = task & 127, b = bh >> 2, h = bh & 3;
    bf16x8 bfr[4];
#pragma unroll
    for (int s = 0; s < 4; ++s) bfr[s] = as_bf16x8(RTf[((size_t)(task * 4 + tn) * 4 + s) * 64 + lane]);
    f32x4 o[8]; float ss = 0.f;
    v4u sfr[8][4];
#pragma unroll
    for (int c = 0; c < 8; ++c) { o[c] = O0c[((size_t)(task * 8 + c) * 4 + tn) * 64 + lane];
#pragma unroll
        for (int s = 0; s < 4; ++s) sfr[c][s] = Sf[((size_t)(task * 8 + c) * 4 + s) * 64 + lane]; }
    const size_t t = (size_t)b * S + n * 64 + 16 * tn + r;
    uint2 zz[8];
#pragma unroll
    for (int c = 0; c < 8; ++c) zz[c] = *(const uint2*)(proj + t * PC + 1536 + h * 128 + 16 * c + 4 * q);
    __builtin_amdgcn_sched_barrier(0);
#pragma unroll
    for (int c = 0; c < 8; ++c) {
        f32x4 a = o[c];
#pragma unroll
        for (int s = 0; s < 4; ++s) a = mfma16(as_bf16x8(sfr[c][s]), bfr[s], a);
        o[c] = a; ss += (a[0] * a[0] + a[1] * a[1]) + (a[2] * a[2] + a[3] * a[3]);
    }
    ss += __shfl_xor(ss, 16); ss += __shfl_xor(ss, 32);
    const float rr = rsqrtf(ss * (1.f / 128.f) + EPS);
#pragma unroll
    for (int c = 0; c < 8; ++c) {
        const int dv0 = 16 * c + 4 * q;
        const uint2 z = zz[c]; const float4 w = *(const float4*)(nw + dv0);
        uint2 y; y.x = pk2(o[c][0] * rr * w.x * siluf_(bf2f(z.x & 0xffffu)), o[c][1] * rr * w.y * siluf_(bf2f(z.x >> 16)));
        y.y = pk2(o[c][2] * rr * w.z * siluf_(bf2f(z.y & 0xffffu)), o[c][3] * rr * w.w * siluf_(bf2f(z.y >> 16)));
        *(uint2*)(mix + t * D + h * 128 + dv0) = y;
    }
}

constexpr int I_WIN = 16 * 96, I_WOUT = 16 * 32, I_WGU = 32 * 16 * 64, I_WD = 32 * 16 * 32, I_ALL = I_WIN + I_WOUT + I_WGU + I_WD;
struct CvItem { const float* src; unsigned char* dst; int ld; int kind; };
__device__ __forceinline__ CvItem cv_decode(int it, const float* w_in, const float* w_out, const float* wgu, const float* wd, bf16* winT, bf16* woutT, unsigned char* wguT, unsigned char* wdT) {
    CvItem d; int r = it;
    if (r < I_WIN) { const int kb = r / 96, nb = r % 96, k0 = 64 * kb; const int scol = nb < 64 ? 32 * nb : 2056 + 32 * (nb - 64);
        d.src = w_in + (size_t)k0 * IN_COLS + scol; d.ld = IN_COLS; d.dst = (unsigned char*)(winT + (size_t)(32 * nb) * 1024 + k0); d.kind = 0; return d; }
    r -= I_WIN;
    if (r < I_WOUT) { const int kb = r / 32, nb = r % 32, k0 = 64 * kb; d.src = w_out + (size_t)k0 * D + 32 * nb; d.ld = D; d.dst = (unsigned char*)(woutT + (size_t)(32 * nb) * 1024 + k0); d.kind = 0; return d; }
    r -= I_WOUT;
    if (r < I_WGU) { const int e = r / 1024, q = r % 1024, kb = q / 64, nb = q % 64, k0 = 64 * kb, n0 = 32 * nb;
        const int half = n0 / 1024, cc = n0 % 1024, pn = cc / 128, j0 = cc % 128, drow = e * 2048 + pn * 256 + half * 128 + j0;
        d.src = wgu + (size_t)e * 1024 * 2048 + (size_t)k0 * 2048 + n0; d.ld = 2048; d.dst = wguT + (size_t)drow * 1024 + k0; d.kind = 1; return d; }
    r -= I_WGU;
    { const int e = r / 512, q = r % 512, kb = q / 32, nb = q % 32, k0 = 64 * kb, n0 = 32 * nb;
      d.src = wd + (size_t)e * 1024 * 1024 + (size_t)k0 * 1024 + n0; d.ld = 1024; d.dst = wdT + (size_t)(e * 1024 + n0) * 1024 + k0; d.kind = 1; return d; }
}
__device__ __forceinline__ void cv_load(const CvItem& d, float (&r)[32], int lane) {
#pragma unroll
    for (int i = 0; i < 32; ++i) r[i] = d.src[(size_t)(2 * i + (lane >> 5)) * d.ld + (lane & 31)];
}
__device__ __forceinline__ void cv_store(const CvItem& d, const float (&r)[32], LAS float* scr, int lane) {
#pragma unroll
    for (int i = 0; i < 32; ++i) scr[(2 * i + (lane >> 5)) * 33 + (lane & 31)] = r[i];
    LDS_WAIT(); asm volatile("" ::: "memory");
    const int c = lane & 7;
    if (d.kind == 0) {
#pragma unroll
        for (int j = 0; j < 4; ++j) { const int n = (lane >> 3) + 8 * j; const LAS float* s = scr + (8 * c) * 33 + n;
            v4u o; o.x = pk2(s[0 * 33], s[1 * 33]); o.y = pk2(s[2 * 33], s[3 * 33]); o.z = pk2(s[4 * 33], s[5 * 33]); o.w = pk2(s[6 * 33], s[7 * 33]);
            *(v4u*)(d.dst + ((size_t)n * 1024 + 8 * c) * 2) = o; }
    } else {
#pragma unroll
        for (int j = 0; j < 4; ++j) { const int n = (lane >> 3) + 8 * j; const LAS float* s = scr + (8 * c) * 33 + n;
            int w0 = 0, w1 = 0;
            w0 = __builtin_amdgcn_cvt_pk_fp8_f32(32.f * s[0 * 33], 32.f * s[1 * 33], w0, false); w0 = __builtin_amdgcn_cvt_pk_fp8_f32(32.f * s[2 * 33], 32.f * s[3 * 33], w0, true);
            w1 = __builtin_amdgcn_cvt_pk_fp8_f32(32.f * s[4 * 33], 32.f * s[5 * 33], w1, false); w1 = __builtin_amdgcn_cvt_pk_fp8_f32(32.f * s[6 * 33], 32.f * s[7 * 33], w1, true);
            *(u32x2*)(d.dst + (size_t)n * 1024 + 8 * c) = (u32x2){(unsigned)w0, (unsigned)w1}; }
    }
    LDS_WAIT(); asm volatile("" ::: "memory");
}
__device__ __forceinline__ void cv_run(int it0, int it_end, int step, const float* w_in, const float* w_out, const float* wgu, const float* wd, bf16* winT, bf16* woutT, unsigned char* wguT, unsigned char* wdT, LAS float* scr, int lane) {
    for (int it = it0; it < it_end; it += step) {
        const CvItem cur = cv_decode(it, w_in, w_out, wgu, wd, winT, woutT, wguT, wdT);
        float r[32]; cv_load(cur, r, lane);
        cv_store(cur, r, scr, lane);
    }
}

constexpr int NWAVES = 8;
constexpr int RING_OFF = 0, RING_BYTES = 131072;
constexpr int LDSCTL_OFF = 144384, MISC_OFF = LDSCTL_OFF + 320;
static_assert(GP_END <= LDSCTL_OFF, "LDS map");
constexpr int LDS_BYTES = 147456;
constexpr int NGOUT = 48;
constexpr int CW_PROG = 65536;
constexpr int CW_BAR = 4096;
enum Phase { PH_PRO = 0, PH_PROJ = 1, PH_CONF = 2, PH_GPREP = 3, PH_GCHAIN = 4, PH_GOUT = 5, PH_OUT = 6, PH_RMS2 = 7, PH_ROUTE = 8, PH_MOE1 = 9, PH_MOE2 = 10, PH_COMB = 11 };
struct Args { const float* in[20]; float* out; unsigned char* ws; unsigned mask; int li; };

__global__ void __launch_bounds__(NWAVES * 64, 2) mega(Args args) {
    extern __shared__ __attribute__((aligned(16))) unsigned char lds[];
    LAS unsigned char* L = (LAS unsigned char*)lds;
    volatile LAS unsigned* MISC = (volatile LAS unsigned*)(L + MISC_OFF);
    const int tid = threadIdx.x, lane = tid & 63, wave = __builtin_amdgcn_readfirstlane(tid >> 6);
    const int G = gridDim.x, bx = blockIdx.x;
    const int vcu = (G % 8 == 0) ? (bx % 8) * (G / 8) + bx / 8 : bx;
#define ws (args.ws)
#define x_in (args.in[0])
#define attn_nw (args.in[1])
#define w_in (args.in[2])
#define gdn_cw (args.in[3])
#define a_log (args.in[4])
#define dt_bias (args.in[5])
#define gdn_nw (args.in[6])
#define cf_dw (args.in[7])
#define cf_db (args.in[8])
#define cf_lw (args.in[9])
#define cf_lb (args.in[10])
#define w_out (args.in[11])
#define ffn_nw (args.in[12])
#define w_router (args.in[13])
#define b_router (args.in[14])
#define wgu (args.in[15])
#define bgu (args.in[16])
#define wd (args.in[17])
#define bd (args.in[18])
#define final_nw (args.in[19])
#define hn ((bf16*)(ws + WS_HN))
#define xn8 ((unsigned char*)(ws + WS_HN))
#define proj ((bf16*)(ws + WS_PROJ))
#define beta ((float*)(ws + WS_BETA))
#define gl ((float*)(ws + WS_G))
#define mix ((bf16*)(ws + WS_MIX))
#define xmid ((bf16*)(ws + WS_XMID))
#define tope ((int*)(ws + WS_TOPE))
#define topg ((float*)(ws + WS_TOPG))
#define pos ((int*)(ws + WS_POS))
#define ghist ((int*)(ws + WS_HIST))
#define blke ((int*)(ws + WS_BLKE))
#define rgate ((float*)(ws + WS_RGATE))
#define wrh ((v4u*)(ws + WS_BLKE + 65536))
#define wrl ((v4u*)(ws + WS_BLKE + 131072))
#define xg ((unsigned char*)(ws + WS_XG))
#define hb ((unsigned char*)(ws + WS_HB))
#define yb ((unsigned char*)(ws + WS_Y))
#define winT ((bf16*)(ws + WS_WINT))
#define woutT ((bf16*)(ws + WS_WOUTT))
#define wguT ((unsigned char*)(ws + WS_WGUT))
#define wdT ((unsigned char*)(ws + WS_WDT))
#define Pf ((v4u*)(ws + WS_XG))
#define Qc ((v4u*)(ws + WS_XG + 32 * MiB))
#define RTf ((v4u*)(ws + WS_XG + 64 * MiB))
#define O0c ((f32x4*)(ws + WS_XG + 80 * MiB))
#define Sf ((v4u*)(ws + WS_XG + 112 * MiB))
#define out (args.out)

    for (int u = tid; u < (LDS_BYTES - LDSCTL_OFF) / 4; u += NWAVES * 64) ((LAS unsigned*)(L + LDSCTL_OFF))[u] = 0u;
    __syncthreads();
    const unsigned mask = args.mask;
    const bool multi = ((mask & 0xFFFu) & ((mask & 0xFFFu) - 1u)) != 0u;
    XcdBarrier bar; bar.bar = (unsigned*)(ws + WS_CTL) + CW_BAR + args.li * XCD_BAR_WORDS; bar.x = 0; bar.st = nullptr;
    if (multi) bar = xcd_barrier_post((unsigned*)(ws + WS_CTL) + CW_BAR + args.li * XCD_BAR_WORDS, MISC + 8);
#define IN(k) ((mask >> (k)) & 1u)
#define SEAM(k) do { if ((mask & 0xFFFu) >> ((k) + 1)) xcd_barrier(bar); } while (0)

    if (IN(PH_PRO)) {
        LAS float* scr = (LAS float*)(L + RING_OFF + wave * 16384);
        const int gw = vcu * NWAVES + wave, NGW = G * NWAVES;
        cv_run(gw, I_WIN, NGW, w_in, w_out, wgu, wd, winT, woutT, wguT, wdT, scr, lane);
        { const int gt = gw * 64 + lane;
          if (gt < 4096) { const int ks = gt >> 7, nt = (gt >> 6) & 1, r = gt & 15, q = (gt >> 4) & 3; unsigned hi[8], lo[8];
#pragma unroll
              for (int j = 0; j < 8; ++j) { const int k = 32 * ks + 8 * q + j; const float w = ffn_nw[k] * w_router[k * NE + 16 * nt + r]; hi[j] = f2bf(w); lo[j] = f2bf(w - bf2f(hi[j])); }
              v4u oh, ol; oh.x = hi[0] | (hi[1] << 16); oh.y = hi[2] | (hi[3] << 16); oh.z = hi[4] | (hi[5] << 16); oh.w = hi[6] | (hi[7] << 16);
              ol.x = lo[0] | (lo[1] << 16); ol.y = lo[2] | (lo[3] << 16); ol.z = lo[4] | (lo[5] << 16); ol.w = lo[6] | (lo[7] << 16);
              wrh[gt] = oh; wrl[gt] = ol; } }
        for (int t = gw * 4; t < T; t += NGW * 4) rms1_tokens<4>(t, lane, x_in, attn_nw, w_in, a_log, dt_bias, hn, beta, gl);
        SEAM(PH_PRO);
    }
    if (IN(PH_PROJ)) {
        pg8::Gemm g{hn, winT, T, PC, D}; pg8::StaticOrder S; S.init(T, PC, G, bx);
        pg8::EpiPlainBf16 E{proj, PC};
        pg8::gemm_phase<pg8::EpiPlainBf16, pg8::StaticOrder, true, true>(L + RING_OFF, g, S, E);
        SEAM(PH_PROJ);
    }
    if (IN(PH_CONF)) {
        for (int tile = bx; tile < T / 64; tile += G) conf_tile(tile, proj, cf_dw, cf_db, cf_lw, cf_lb, mix, (float*)(lds + RING_OFF));
        if (!IN(PH_GPREP)) SEAM(PH_CONF);
    }
    if (IN(PH_GPREP)) {
        for (int task = bx; task < 1024; task += G) gdn_prep_task(task, L, proj, gdn_cw, beta, gl, Pf, Qc, RTf, O0c);
        SEAM(PH_GPREP);
    }
    if (IN(PH_GCHAIN)) {
        if (bx < 64) {
            if (tid < 16) ((volatile LAS int*)(L + CH_FLAGS))[tid] = 0;
            __syncthreads();
            { if (wave == 0) gdn_chain_consumer(bx & 7, bx >> 3, lane, L, Sf, (unsigned*)(ws + WS_CTL) + CW_PROG + ((bx & 7) * 8 + (bx >> 3)) * 64); else if (wave < 7) gdn_chain_loader(wave - 1, bx & 7, bx >> 3, lane, L, Pf, Qc); }
        }
        else if (bx < 64 + NGOUT) {
            for (int p = bx - 64; p < 512; p += NGOUT) {
                const int n = p >> 2, bh0 = 2 * (p & 3);
                if (wave == 0) {
                    const unsigned* pw = (const unsigned*)(ws + WS_CTL) + CW_PROG + ((bh0 + ((lane >> 3) & 1)) * 8 + (lane & 7)) * 64;
                    unsigned sp = 0;
                    for (;;) { const unsigned v = __hip_atomic_load(pw, __ATOMIC_RELAXED, __HIP_MEMORY_SCOPE_AGENT); if (__all((lane >= 16) || (v >= (unsigned)(n + 1)))) break; __builtin_amdgcn_s_sleep(32); if (++sp > (1u << 20)) break; }
                    __builtin_amdgcn_fence(__ATOMIC_ACQUIRE, "agent");
                    asm volatile("s_waitcnt vmcnt(0)" ::: "memory");
                }
                __syncthreads();
                gdn_out_wave((bh0 + (wave >> 2)) * 128 + n, wave & 3, lane, Sf, RTf, O0c, proj, gdn_nw, mix);
                __syncthreads();
            }
        }
        else {
            {
                LAS float* scr = (LAS float*)(L + RING_OFF + wave * 16384);
                const int gw = (bx - 64 - NGOUT) * NWAVES + wave, NGW = (G - 64 - NGOUT) * NWAVES;
                cv_run(I_WIN + gw, I_ALL, NGW, w_in, w_out, wgu, wd, winT, woutT, wguT, wdT, scr, lane);
            }
        }
        SEAM(PH_GCHAIN);
    }
    if (IN(PH_OUT)) {
        pg8::Gemm g{mix, woutT, T, D, D}; pg8::StaticOrder S; S.init(T, D, G, bx);
        pg8::EpiResBf16 E{xmid, x_in, D};
        pg8::gemm_phase<pg8::EpiResBf16, pg8::StaticOrder, true, true>(L + RING_OFF, g, S, E);
        SEAM(PH_OUT);
    }
    if (IN(PH_RMS2)) {
        for (int grp = bx; grp < NWG; grp += G) rms2_group(grp, xmid, ffn_nw, wrh, wrl, b_router, xn8, tope, topg, ghist, lds + RING_OFF);
        SEAM(PH_RMS2);
    }
    if (IN(PH_ROUTE)) {
        for (int grp = bx; grp < NWG; grp += G) route_group(grp, ghist, tope, topg, xn8, pos, rgate, blke, xg, (int*)(lds + RING_OFF));
        SEAM(PH_ROUTE);
    }
    if (IN(PH_MOE1)) {
        pg8::Gemm g{(const pg8::bf16_t*)xg, (const pg8::bf16_t*)wguT, RPAD, 2048, D / 2}; pg8::MoeOrder S; S.init(blke, MAXBLK, 8, G, bx);
        pg8::EpiSwiglu E{hb, bgu};
        pg8::gemm_phase<pg8::EpiSwiglu, pg8::MoeOrder, true, true, 122, 127>(L + RING_OFF, g, S, E);
        SEAM(PH_MOE1);
    }
    if (IN(PH_MOE2)) {
        pg8::Gemm g{(const pg8::bf16_t*)hb, (const pg8::bf16_t*)wdT, RPAD, D, FF / 2}; pg8::MoeOrder S; S.init(blke, MAXBLK, 4, G, bx);
        pg8::EpiDown E{yb, bd, rgate};
        pg8::gemm_phase<pg8::EpiDown, pg8::MoeOrder, true, true, 122, 125>(L + RING_OFF, g, S, E);
        SEAM(PH_MOE2);
    }
    if (IN(PH_COMB)) {
        const int gw = vcu * NWAVES + wave, NGW = G * NWAVES;
        for (int t = gw; t < T; t += NGW) combine_token(t, lane, xmid, yb, pos, final_nw, out);
    }
#undef IN
#undef SEAM
#undef ws
#undef x_in
#undef attn_nw
#undef w_in
#undef gdn_cw
#undef a_log
#undef dt_bias
#undef gdn_nw
#undef cf_dw
#undef cf_db
#undef cf_lw
#undef cf_lb
#undef w_out
#undef ffn_nw
#undef w_router
#undef b_router
#undef wgu
#undef bgu
#undef wd
#undef bd
#undef final_nw
#undef hn
#undef proj
#undef beta
#undef gl
#undef mix
#undef xmid
#undef tope
#undef topg
#undef pos
#undef ghist
#undef blke
#undef rgate
#undef wrh
#undef wrl
#undef xg
#undef hb
#undef yb
#undef winT
#undef woutT
#undef wguT
#undef wdT
#undef Pf
#undef Qc
#undef RTf
#undef O0c
#undef Sf
#undef out
}

extern "C" void kernel_launch(void* const* d_in, const int* in_sizes, int n_in, void* d_out, int out_size, void* d_ws, size_t ws_size, hipStream_t stream) {
    static int grid = 0;
    if (grid == 0) {
        if (n_in != 20 || ws_size < WS_END) { fprintf(stderr, "kernel_launch: unexpected n_in %d / ws %zu (need %zu)\n", n_in, ws_size, (size_t)WS_END); grid = -1; return; }
        int dev = 0, cus = 0, per_cu = 0;
        if (hipGetDevice(&dev) != hipSuccess || hipDeviceGetAttribute(&cus, hipDeviceAttributeMultiprocessorCount, dev) != hipSuccess) { grid = -1; return; }
        if (hipFuncSetAttribute((const void*)mega, hipFuncAttributeMaxDynamicSharedMemorySize, LDS_BYTES) != hipSuccess) { fprintf(stderr, "kernel_launch: hipFuncSetAttribute failed\n"); grid = -1; return; }
        if (hipOccupancyMaxActiveBlocksPerMultiprocessor(&per_cu, (const void*)mega, NWAVES * 64, LDS_BYTES) != hipSuccess || per_cu < 1) { fprintf(stderr, "kernel_launch: occupancy query says %d\n", per_cu); }
        (void)hipGetLastError();
        grid = cus;
    }
    if (grid < 0) return;
    unsigned char* ws = (unsigned char*)d_ws;
    if (hipMemsetAsync(ws + WS_CTL, 0, 1 * MiB, stream) != hipSuccess) return;
    Args a{};
    for (int i = 0; i < 20; ++i) a.in[i] = (const float*)d_in[i];
    a.out = (float*)d_out; a.ws = ws;
    a.mask = 0xFFFu & ~(1u << PH_GOUT); a.li = 0;
    hipLaunchKernelGGL(mega, dim3(grid), dim3(NWAVES * 64), LDS_BYTES, stream, a);
}
```

```cpp
#include <hip/hip_runtime.h>
#include <cstdint>
#include <cstdio>
#include <type_traits>

namespace cfg {
constexpr int B = 2, S = 8192, T = B * S, D = 1024;
constexpr int H = 4, DK = 128, DV = 128, QK = 512;
constexpr int CF = 512, CFK = 31, NE = 32, TOPK = 4, FF = 1024;
constexpr int OFF_B = 2048, OFF_A = 2052, OFF_CF = 2056, IN_COLS = 3080;
constexpr int PC = 3072;
constexpr float EPS = 1e-6f;
constexpr int RB = 256;
constexpr int MAXBLK = 256 + 32;
constexpr int RPAD = MAXBLK * RB;
constexpr int NWG = 256;
}
using namespace cfg;

typedef unsigned short bf16;
__device__ __forceinline__ unsigned f2bf(float f) { unsigned u = __builtin_bit_cast(unsigned, f); return (u + 0x7fffu + ((u >> 16) & 1u)) >> 16; }
__device__ __forceinline__ float bf2f(unsigned h) { return __builtin_bit_cast(float, h << 16); }
__device__ __forceinline__ unsigned pk2(float lo, float hi) { return f2bf(lo) | (f2bf(hi) << 16); }
__device__ __forceinline__ float sigmoidf_(float x) { return __builtin_amdgcn_rcpf(1.f + __expf(-x)); }
__device__ __forceinline__ float siluf_(float x) { return x * sigmoidf_(x); }
__device__ __forceinline__ float softplusf_(float x) { return fmaxf(x, 0.f) + log1pf(__expf(-fabsf(x))); }
__device__ __forceinline__ float wave_sum(float v) {
    v += __builtin_bit_cast(float, __builtin_amdgcn_update_dpp(0, __builtin_bit_cast(int, v), 0x111, 0xf, 0xf, false));
    v += __builtin_bit_cast(float, __builtin_amdgcn_update_dpp(0, __builtin_bit_cast(int, v), 0x112, 0xf, 0xf, false));
    v += __builtin_bit_cast(float, __builtin_amdgcn_update_dpp(0, __builtin_bit_cast(int, v), 0x114, 0xf, 0xf, false));
    v += __builtin_bit_cast(float, __builtin_amdgcn_update_dpp(0, __builtin_bit_cast(int, v), 0x118, 0xf, 0xf, false));
    v += __builtin_bit_cast(float, __builtin_amdgcn_update_dpp(0, __builtin_bit_cast(int, v), 0x142, 0xa, 0xf, false));
    v += __builtin_bit_cast(float, __builtin_amdgcn_update_dpp(0, __builtin_bit_cast(int, v), 0x143, 0xc, 0xf, false));
    return __builtin_bit_cast(float, __builtin_amdgcn_readlane(__builtin_bit_cast(int, v), 63));
}

constexpr size_t MiB = 1u << 20;
constexpr size_t WS_CTL = 0;
constexpr size_t WS_HN = 1 * MiB;
constexpr size_t WS_PROJ = WS_HN + 32 * MiB;
constexpr size_t WS_BETA = WS_PROJ + 96 * MiB;
constexpr size_t WS_G = WS_BETA + 1 * MiB;
constexpr size_t WS_MIX = WS_G + 1 * MiB;
constexpr size_t WS_XMID = WS_MIX + 32 * MiB;
constexpr size_t WS_TOPE = WS_XMID + 64 * MiB;
constexpr size_t WS_TOPG = WS_TOPE + 1 * MiB;
constexpr size_t WS_POS = WS_TOPG + 1 * MiB;
constexpr size_t WS_HIST = WS_POS + 1 * MiB;
constexpr size_t WS_BLKE = WS_HIST + 1 * MiB;
constexpr size_t WS_RGATE = WS_BLKE + 1 * MiB;
constexpr size_t WS_XG = WS_RGATE + 1 * MiB;
constexpr size_t WS_HB = WS_XG + 144 * MiB;
constexpr size_t WS_Y = WS_HB + 144 * MiB;
constexpr size_t WS_WINT = WS_Y + 144 * MiB;
constexpr size_t WS_WOUTT = WS_WINT + 6 * MiB;
constexpr size_t WS_WGUT = WS_WOUTT + 2 * MiB;
constexpr size_t WS_WDT = WS_WGUT + 128 * MiB;
constexpr size_t WS_END = WS_WDT + 64 * MiB;


#define GAS __attribute__((address_space(1)))
#define LAS __attribute__((address_space(3)))
typedef unsigned v4u __attribute__((ext_vector_type(4)));
#define LDS_WAIT() asm volatile("s_waitcnt lgkmcnt(0)" ::: "memory")
#define VM_WAIT() asm volatile("s_waitcnt vmcnt(0)" ::: "memory")

namespace pg8 {
#define PG8_LAS __attribute__((address_space(3)))
typedef unsigned short bf16_t;
typedef short bf16x8 __attribute__((ext_vector_type(8)));
typedef float f32x4 __attribute__((ext_vector_type(4)));
typedef unsigned u32x4 __attribute__((ext_vector_type(4)));
constexpr int BM = 256, BK = 64, HALF = 128, HTB = HALF * BK * 2  , STAGE_BYTES = 8 * HTB, NXCD = 8, WGM = 8;

__host__ __device__ __forceinline__ int lds_byte(int r, int c) { const int st = (r >> 4) * 2 + (c >> 5), rr = r & 15, cc = c & 31, ob = rr * 64 + cc * 2; return st * 1024 + (ob ^ (((ob >> 9) & 1) << 5)); }
__host__ __device__ __forceinline__ void stage_rc(int b, int& R, int& C) { const int st = b / 1024, sb = b % 1024, swz = sb ^ (((sb >> 9) & 1) << 5); R = (st >> 1) * 16 + swz / 64; C = (st & 1) * 32 + (swz % 64) / 2; }
__host__ __device__ __forceinline__ int perm32(int rho) { const int n = rho >> 4, i = rho & 15; return 8 * (i >> 2) + 4 * n + (i & 3); }

struct Unit { int pm, pn, pb, e; };
struct Gemm { const bf16_t* A; const bf16_t* Bt; int M, N, K; const int* rowidx = nullptr; };

struct StaticOrder {
    int nM, nN, nwg, G, c;
    __host__ __device__ void init(int M, int N, int G_, int c_) { nM = M / BM; nN = N / BM; nwg = nM * nN; G = G_; c = c_; }
    __host__ __device__ bool next(int i, Unit& u) const {
        const long L = (long)i * G + c; if (L >= nwg) return false;
        int wgid = (int)L; { const int q = nwg / NXCD, r = nwg % NXCD, xcd = wgid % NXCD, off = wgid / NXCD; wgid = (xcd < r ? xcd * (q + 1) : r * (q + 1) + (xcd - r) * q) + off; }
        const int nig = WGM * nN, gid = wgid / nig, fm = gid * WGM, gsz = (nM - fm) < WGM ? (nM - fm) : WGM;
        u.pm = fm + ((wgid % nig) % gsz); u.pn = (wgid % nig) / gsz; u.pb = u.pn; u.e = 0; return true;
    }
    __device__ __forceinline__ void a_ready(const Unit&) const {}
    __device__ __forceinline__ void done(const Unit&) const {}
};

__device__ __forceinline__ unsigned cvt_pk_bf16(float lo, float hi) { unsigned r; asm volatile("v_cvt_pk_bf16_f32 %0, %1, %2" : "=v"(r) : "v"(lo), "v"(hi)); return r; }
__device__ __forceinline__ int ld_i32_sc1(const int* p) { return (int)__hip_atomic_load((const unsigned*)p, __ATOMIC_RELAXED, __HIP_MEMORY_SCOPE_AGENT); }
struct MoeOrder {
    int nM, nN, nwg, G, c; const int* blke;
    __device__ void init(const int* blke_, int nblk_slot, int nN_, int G_, int c_) { blke = blke_; nM = ld_i32_sc1(blke_ + nblk_slot); nN = nN_; nwg = nM * nN; G = G_; c = c_; }
    __device__ bool next(int i, Unit& u) const {
        const long L = (long)i * G + c; if (L >= nwg) return false;
        int wgid = (int)L; { const int q = nwg / NXCD, r = nwg % NXCD, xcd = wgid % NXCD, off = wgid / NXCD; wgid = (xcd < r ? xcd * (q + 1) : r * (q + 1) + (xcd - r) * q) + off; }
        const int nig = WGM * nN, gid = wgid / nig, fm = gid * WGM, gsz = (nM - fm) < WGM ? (nM - fm) : WGM;
        u.pm = fm + ((wgid % nig) % gsz); u.pn = (wgid % nig) / gsz; u.e = ld_i32_sc1(blke + u.pm); u.pb = u.e * nN + u.pn; return true;
    }
    __device__ __forceinline__ void a_ready(const Unit&) const {}
    __device__ __forceinline__ void done(const Unit&) const {}
};
struct EpiResBf16 {
    static constexpr bool PERM = true, AFTER_DRAIN = false;
    bf16_t* O; const float* R; int ldc;
    __device__ __forceinline__ void operator()(const f32x4 (&acc)[2][2][4][2], const Unit& u, int wr, int wc, int fr, int fq) const {
        const int row0 = u.pm * BM + wr * 64 + fr, col0 = u.pn * BM + wc * 32 + 8 * fq;
#pragma unroll
        for (int ai = 0; ai < 2; ++ai)
#pragma unroll
            for (int m = 0; m < 4; ++m) { const size_t ro = (size_t)(row0 + ai * HALF + m * 16) * ldc + col0;
#pragma unroll
                for (int bj = 0; bj < 2; ++bj) { const f32x4 v0 = acc[ai][bj][m][0] + *(const f32x4*)(R + ro + bj * HALF), v1 = acc[ai][bj][m][1] + *(const f32x4*)(R + ro + bj * HALF + 4);
                    u32x4 w; w.x = cvt_pk_bf16(v0[0], v0[1]); w.y = cvt_pk_bf16(v0[2], v0[3]); w.z = cvt_pk_bf16(v1[0], v1[1]); w.w = cvt_pk_bf16(v1[2], v1[3]);
                    *(u32x4*)(O + ro + bj * HALF) = w; } }
    }
};
struct EpiSwiglu {
    static constexpr bool PERM = true, AFTER_DRAIN = false;
    unsigned char* O; const float* bgu;
    __device__ __forceinline__ void operator()(const f32x4 (&acc)[2][2][4][2], const Unit& u, int wr, int wc, int fr, int fq) const {
        const int row0 = u.pm * BM + wr * 64 + fr, colg = u.pn * HALF + wc * 32 + 8 * fq;
        const float* bg = bgu + (size_t)u.e * 2048 + colg;
        const f32x4 bgv[2] = {*(const f32x4*)bg, *(const f32x4*)(bg + 4)}, buv[2] = {*(const f32x4*)(bg + 1024), *(const f32x4*)(bg + 1028)};
#pragma unroll
        for (int ai = 0; ai < 2; ++ai)
#pragma unroll
            for (int m = 0; m < 4; ++m) { unsigned char* rowp = O + (size_t)(row0 + ai * HALF + m * 16) * 1024 + colg;
                float r[8];
#pragma unroll
                for (int n = 0; n < 2; ++n) { const f32x4 g = acc[ai][0][m][n] + bgv[n], uu = acc[ai][1][m][n] + buv[n];
#pragma unroll
                    for (int i = 0; i < 4; ++i) { const float gc = fminf(g[i], 7.f), uc = fminf(fmaxf(uu[i], -7.f), 7.f);
                        r[4 * n + i] = 4.f * (uc + 1.f) * gc * __builtin_amdgcn_rcpf(1.f + __expf(-1.702f * gc)); } }
                int w0 = 0, w1 = 0;
                w0 = __builtin_amdgcn_cvt_pk_fp8_f32(r[0], r[1], w0, false); w0 = __builtin_amdgcn_cvt_pk_fp8_f32(r[2], r[3], w0, true);
                w1 = __builtin_amdgcn_cvt_pk_fp8_f32(r[4], r[5], w1, false); w1 = __builtin_amdgcn_cvt_pk_fp8_f32(r[6], r[7], w1, true);
                typedef unsigned u32x2_ __attribute__((ext_vector_type(2)));
                *(u32x2_*)rowp = (u32x2_){(unsigned)w0, (unsigned)w1}; }
    }
};
struct EpiDown {
    static constexpr bool PERM = true, AFTER_DRAIN = false;
    unsigned char* O; const float* bd; const float* rgate;
    __device__ __forceinline__ void operator()(const f32x4 (&acc)[2][2][4][2], const Unit& u, int wr, int wc, int fr, int fq) const {
        const int row0 = u.pm * BM + wr * 64 + fr, col0 = u.pn * BM + wc * 32 + 8 * fq;
        const float* bp = bd + (size_t)u.e * 1024 + col0;
        f32x4 bv[2][2];
#pragma unroll
        for (int bj = 0; bj < 2; ++bj)
#pragma unroll
            for (int n = 0; n < 2; ++n) bv[bj][n] = *(const f32x4*)(bp + bj * HALF + 4 * n);
#pragma unroll
        for (int ai = 0; ai < 2; ++ai)
#pragma unroll
            for (int m = 0; m < 4; ++m) { const int row = row0 + ai * HALF + m * 16; const float sc = 16.f * __hip_atomic_load(rgate + row, __ATOMIC_RELAXED, __HIP_MEMORY_SCOPE_AGENT);
                unsigned char* rowp = O + (size_t)row * 1024 + col0;
#pragma unroll
                for (int bj = 0; bj < 2; ++bj) { f32x4 v0 = (acc[ai][bj][m][0] + bv[bj][0]) * sc, v1 = (acc[ai][bj][m][1] + bv[bj][1]) * sc;
#pragma unroll
                    for (int i = 0; i < 4; ++i) { v0[i] = __builtin_amdgcn_fmed3f(v0[i], -448.f, 448.f); v1[i] = __builtin_amdgcn_fmed3f(v1[i], -448.f, 448.f); }
                    int w0 = 0, w1 = 0;
                    w0 = __builtin_amdgcn_cvt_pk_fp8_f32(v0[0], v0[1], w0, false); w0 = __builtin_amdgcn_cvt_pk_fp8_f32(v0[2], v0[3], w0, true);
                    w1 = __builtin_amdgcn_cvt_pk_fp8_f32(v1[0], v1[1], w1, false); w1 = __builtin_amdgcn_cvt_pk_fp8_f32(v1[2], v1[3], w1, true);
                    typedef unsigned u32x2_ __attribute__((ext_vector_type(2)));
                    *(u32x2_*)(rowp + bj * HALF) = (u32x2_){(unsigned)w0, (unsigned)w1}; } }
    }
};
struct EpiPlainBf16 {
    static constexpr bool PERM = true, AFTER_DRAIN = false;
    bf16_t* O; int ldc;
    __device__ __forceinline__ void operator()(const f32x4 (&acc)[2][2][4][2], const Unit& u, int wr, int wc, int fr, int fq) const {
        const int row0 = u.pm * BM + wr * 64 + fr, col0 = u.pn * BM + wc * 32 + 8 * fq;
#pragma unroll
        for (int ai = 0; ai < 2; ++ai)
#pragma unroll
            for (int m = 0; m < 4; ++m) { bf16_t* rowp = O + (size_t)(row0 + ai * HALF + m * 16) * ldc + col0;
#pragma unroll
                for (int bj = 0; bj < 2; ++bj) { const f32x4 v0 = acc[ai][bj][m][0], v1 = acc[ai][bj][m][1];
                    u32x4 w; w.x = cvt_pk_bf16(v0[0], v0[1]); w.y = cvt_pk_bf16(v0[2], v0[3]); w.z = cvt_pk_bf16(v1[0], v1[1]); w.w = cvt_pk_bf16(v1[2], v1[3]);
                    *(u32x4*)(rowp + bj * HALF) = w; } }
    }
};
constexpr int GIDX_OFF = 131072, GIDX_UNITS = 12;
template <class Epi, class Sched, bool ALIGN_EPI = false, bool SP2 = false, int F8W = 0, int F8A = 0, bool GATHER = false>
__device__ __forceinline__ void gemm_phase(PG8_LAS unsigned char* lds, const Gemm g, const Sched& S, const Epi& E) {
    const int tid = threadIdx.x, wid = __builtin_amdgcn_readfirstlane(tid >> 6), lane = tid & 63, wr = wid >> 2, wc = wid & 3, fr = lane & 15, fq = lane >> 4;
    const int K = g.K, nt = K / BK;
    static_assert(!GATHER || SP2, "GATHER is wired into the SP2 loop only");
    unsigned voffA[2], voffB[2]; int gR[2]; unsigned gC[2];
#pragma unroll
    for (int i = 0; i < 2; ++i) { int R, C; stage_rc(tid * 16 + i * 8192, R, C); const int Rb = Epi::PERM ? ((R & ~31) + perm32(R & 31)) : R;
        voffA[i] = (unsigned)(R * K + C) * 2u; voffB[i] = (unsigned)(Rb * K + C) * 2u; gR[i] = R; gC[i] = (unsigned)C * 2u; }
    PG8_LAS int* gidx = (PG8_LAS int*)(lds + GIDX_OFF);
    unsigned cv[2][2], sv[2][2];
#define PG8_GOFFS(dst, u) do { _Pragma("unroll") for (int h_ = 0; h_ < 2; ++h_) _Pragma("unroll") for (int i_ = 0; i_ < 2; ++i_) dst[h_][i_] = (unsigned)gidx[(u) * 256 + h_ * HALF + gR[i_]] * (unsigned)(K * 2) + gC[i_]; } while (0)
#define PG8_STAGE_G(bufoff, kbyte, offs) do { _Pragma("unroll") for (int _i = 0; _i < 2; ++_i) \
        __builtin_amdgcn_global_load_lds((const unsigned*)((const char*)g.A + (size_t)(kbyte) + (offs)[_i]), (PG8_LAS unsigned*)(lds + (bufoff) + ldsw + _i * 8192), 16, 0, 0); } while (0)
    const size_t kstep = (size_t)(BK * 2);
    const size_t hstep = (size_t)HALF * K * 2;
    const size_t tstep = 2 * hstep;
    const unsigned ldsw = (unsigned)wid * 1024u;
    const int aoff = lds_byte(wr * 64 + fr, fq * 8), boff = lds_byte(wc * 32 + fr, fq * 8);
#define PG8_SA(b, h) (((b) * 2 + (h)) * HTB)
#define PG8_SB(b, h) ((4 + (b) * 2 + (h)) * HTB)
#define PG8_STAGE(bufoff, gbase, voff) do { _Pragma("unroll") for (int _i = 0; _i < 2; ++_i) \
        __builtin_amdgcn_global_load_lds((const unsigned*)((const char*)(gbase) + (voff)[_i]), (PG8_LAS unsigned*)(lds + (bufoff) + ldsw + _i * 8192), 16, 0, 0); } while (0)
#define PG8_LD1(dst, addr) do { if constexpr (F8W != 0) { (dst).v = __builtin_shufflevector(*(const PG8_LAS i32x4_*)(addr), *(const PG8_LAS i32x4_*)((addr) + 1024), 0, 1, 2, 3, 4, 5, 6, 7); } \
        else { (dst).v[0] = *(const PG8_LAS bf16x8*)(addr); (dst).v[1] = *(const PG8_LAS bf16x8*)((addr) + 1024); } } while (0)
#define PG8_LDA(dst, b, h) do { _Pragma("unroll") for (int m = 0; m < 4; ++m) PG8_LD1(dst[m], lds + PG8_SA(b, h) + aoff + m * 2048); } while (0)
#define PG8_LDB(dst, b, h) do { _Pragma("unroll") for (int n = 0; n < 2; ++n) PG8_LD1(dst[n], lds + PG8_SB(b, h) + boff + n * 2048); } while (0)
#define PG8_MMA(ai, bj, At, Bt) do { __builtin_amdgcn_s_setprio(1); _Pragma("unroll") for (int m = 0; m < 4; ++m) _Pragma("unroll") for (int n = 0; n < 2; ++n) { \
        if constexpr (F8W != 0) { asm volatile("v_mfma_scale_f32_16x16x128_f8f6f4 %0, %1, %2, %0, %3, %4 op_sel_hi:[0,0,0]" : "+v"(acc[ai][bj][m][n]) : "v"(Bt[n].v), "v"(At[m].v), "v"(f8sw), "v"(f8sa)); } \
        else { _Pragma("unroll") for (int k = 0; k < 2; ++k) acc[ai][bj][m][n] = __builtin_amdgcn_mfma_f32_16x16x32_bf16(Bt[n].v[k], At[m].v[k], acc[ai][bj][m][n], 0, 0, 0); } } \
        __builtin_amdgcn_s_setprio(0); } while (0)
#define PG8_WAIT_V(n) asm volatile("s_waitcnt vmcnt(" #n ")" ::: "memory")
#define PG8_WAIT_L(n) asm volatile("s_waitcnt lgkmcnt(" #n ")" ::: "memory")
#define PG8_BAR __builtin_amdgcn_s_barrier()
#define PG8_SCHED __builtin_amdgcn_sched_barrier(0)
    Unit cur, nxt; int ui = 0;
    if (!S.next(0, cur)) return;
    if constexpr (GATHER) {
        Unit tu;
        for (int u = 0; u < GIDX_UNITS && S.next(u, tu); ++u) if (tid < 256) gidx[u * 256 + tid] = g.rowidx[(size_t)tu.pm * 256 + tid];
        asm volatile("s_waitcnt vmcnt(0) lgkmcnt(0)" ::: "memory"); __builtin_amdgcn_s_barrier(); asm volatile("" ::: "memory");
        PG8_GOFFS(cv, 0);
    }
    f32x4 acc[2][2][4][2];
#pragma unroll
    for (int a = 0; a < 2; ++a)
#pragma unroll
        for (int b = 0; b < 2; ++b)
#pragma unroll
            for (int m = 0; m < 4; ++m)
#pragma unroll
                for (int n = 0; n < 2; ++n) acc[a][b][m][n] = (f32x4){0.f, 0.f, 0.f, 0.f};
    typedef int i32x4_ __attribute__((ext_vector_type(4))); typedef int i32x8_ __attribute__((ext_vector_type(8)));
    struct FragBf { bf16x8 v[2]; }; struct FragF8 { i32x8_ v; };
    typedef typename std::conditional<F8W != 0, FragF8, FragBf>::type Frag;
    Frag At[4], B0[2], B1[2];
    const int f8sw = F8W, f8sa = F8A;
    const char* cA = (const char*)g.A + (size_t)cur.pm * tstep; const char* cB = (const char*)g.Bt + (size_t)cur.pb * tstep;
    S.a_ready(cur);
    if constexpr (SP2) {
        PG8_STAGE(PG8_SB(0, 0), cB, voffB); PG8_STAGE(PG8_SB(0, 1), cB + hstep, voffB);
        if constexpr (GATHER) { PG8_STAGE_G(PG8_SA(0, 0), 0, cv[0]); PG8_STAGE_G(PG8_SA(0, 1), 0, cv[1]); } else { PG8_STAGE(PG8_SA(0, 0), cA, voffA); PG8_STAGE(PG8_SA(0, 1), cA + hstep, voffA); }
        if (wr == 1) PG8_BAR;
        PG8_WAIT_V(2); PG8_BAR;
        PG8_STAGE(PG8_SB(1, 0), cB + kstep, voffB);
        if constexpr (GATHER) { PG8_STAGE_G(PG8_SA(1, 0), kstep, cv[0]); } else { PG8_STAGE(PG8_SA(1, 0), cA + kstep, voffA); }
        PG8_STAGE(PG8_SB(1, 1), cB + hstep + kstep, voffB);
        PG8_WAIT_V(6); PG8_BAR;
    } else {
        PG8_STAGE(PG8_SB(0, 0), cB, voffB); PG8_STAGE(PG8_SA(0, 0), cA, voffA); PG8_STAGE(PG8_SB(0, 1), cB + hstep, voffB); PG8_STAGE(PG8_SA(0, 1), cA + hstep, voffA);
        if (wr == 1) PG8_BAR;
        PG8_WAIT_V(4); PG8_BAR;
        PG8_STAGE(PG8_SB(1, 0), cB + kstep, voffB); PG8_STAGE(PG8_SA(1, 0), cA + kstep, voffA); PG8_STAGE(PG8_SB(1, 1), cB + hstep + kstep, voffB);
        PG8_WAIT_V(6); PG8_BAR;
    }
    for (;;) {
        const bool has_next = S.next(ui + 1, nxt);
        const char* nA = has_next ? (const char*)g.A + (size_t)nxt.pm * tstep : cA; const char* nB = has_next ? (const char*)g.Bt + (size_t)nxt.pb * tstep : cB;
        for (int t = 0; t < nt; t += 2) {
            const bool last = (t == nt - 2);
            const char* a1 = cA + (size_t)(t + 1) * kstep;
            const char* a2 = last ? nA : cA + (size_t)(t + 2) * kstep; const char* b2 = last ? nB : cB + (size_t)(t + 2) * kstep;
            const char* a3 = a2 + kstep; const char* b3 = b2 + kstep;
            if (last && has_next) S.a_ready(nxt);
            size_t kb2 = 0;
            if constexpr (GATHER) {
                kb2 = last ? 0 : (size_t)(t + 2) * kstep;
                if (last && has_next) { PG8_GOFFS(sv, ui + 1); } else {
#pragma unroll
                    for (int h_ = 0; h_ < 2; ++h_)
#pragma unroll
                        for (int i_ = 0; i_ < 2; ++i_) sv[h_][i_] = cv[h_][i_]; }
            }
            if constexpr (SP2) {
            PG8_LDB(B0, 0, 0); PG8_LDB(B1, 0, 1); PG8_SCHED; PG8_LDA(At, 0, 0); if constexpr (GATHER) { PG8_STAGE_G(PG8_SA(1, 1), (size_t)(t + 1) * kstep, cv[1]); } else { PG8_STAGE(PG8_SA(1, 1), a1 + hstep, voffA); }
            PG8_WAIT_V(8); PG8_WAIT_L(0); PG8_BAR; PG8_MMA(0, 0, At, B0); PG8_MMA(0, 1, At, B1); PG8_BAR; PG8_SCHED;
            PG8_LDA(At, 0, 1); PG8_STAGE(PG8_SB(0, 0), b2, voffB); PG8_STAGE(PG8_SB(0, 1), b2 + hstep, voffB); if constexpr (GATHER) { PG8_STAGE_G(PG8_SA(0, 0), kb2, sv[0]); } else { PG8_STAGE(PG8_SA(0, 0), a2, voffA); }
            PG8_WAIT_V(8); PG8_WAIT_L(0); PG8_BAR; PG8_MMA(1, 0, At, B0); PG8_MMA(1, 1, At, B1); PG8_BAR; PG8_SCHED;
            PG8_LDB(B0, 1, 0); PG8_LDB(B1, 1, 1); PG8_SCHED; PG8_LDA(At, 1, 0); if constexpr (GATHER) { PG8_STAGE_G(PG8_SA(0, 1), kb2, sv[1]); } else { PG8_STAGE(PG8_SA(0, 1), a2 + hstep, voffA); }
            PG8_WAIT_V(8); PG8_WAIT_L(0); PG8_BAR; PG8_MMA(0, 0, At, B0); PG8_MMA(0, 1, At, B1); PG8_BAR; PG8_SCHED;
            PG8_LDA(At, 1, 1); PG8_STAGE(PG8_SB(1, 0), b3, voffB); PG8_STAGE(PG8_SB(1, 1), b3 + hstep, voffB); if constexpr (GATHER) { PG8_STAGE_G(PG8_SA(1, 0), kb2 + kstep, sv[0]); } else { PG8_STAGE(PG8_SA(1, 0), a3, voffA); }
            PG8_WAIT_V(8); PG8_WAIT_L(0); PG8_BAR; PG8_MMA(1, 0, At, B0); PG8_MMA(1, 1, At, B1); PG8_BAR; PG8_SCHED;
            } else {
            PG8_LDB(B0, 0, 0); PG8_SCHED; PG8_LDA(At, 0, 0); PG8_STAGE(PG8_SA(1, 1), a1 + hstep, voffA);
            PG8_WAIT_L(8); PG8_BAR; PG8_WAIT_L(0); PG8_MMA(0, 0, At, B0); PG8_BAR; PG8_SCHED;
            PG8_LDB(B1, 0, 1); PG8_STAGE(PG8_SB(0, 0), b2, voffB);
            PG8_BAR; PG8_WAIT_L(0); PG8_MMA(0, 1, At, B1); PG8_BAR;
            PG8_LDA(At, 0, 1); PG8_STAGE(PG8_SA(0, 0), a2, voffA);
            PG8_BAR; PG8_WAIT_L(0); PG8_MMA(1, 0, At, B0); PG8_BAR; PG8_SCHED;
            PG8_STAGE(PG8_SB(0, 1), b2 + hstep, voffB);
            PG8_WAIT_V(6); PG8_BAR; PG8_MMA(1, 1, At, B1); PG8_BAR;
            PG8_LDB(B0, 1, 0); PG8_SCHED; PG8_LDA(At, 1, 0); PG8_STAGE(PG8_SA(0, 1), a2 + hstep, voffA);
            PG8_WAIT_L(8); PG8_BAR; PG8_WAIT_L(0); PG8_MMA(0, 0, At, B0); PG8_BAR; PG8_SCHED;
            PG8_LDB(B1, 1, 1); PG8_STAGE(PG8_SB(1, 0), b3, voffB);
            PG8_BAR; PG8_WAIT_L(0); PG8_MMA(0, 1, At, B1); PG8_BAR;
            PG8_LDA(At, 1, 1); PG8_STAGE(PG8_SA(1, 0), a3, voffA);
            PG8_BAR; PG8_WAIT_L(0); PG8_MMA(1, 0, At, B0); PG8_BAR; PG8_SCHED;
            PG8_STAGE(PG8_SB(1, 1), b3 + hstep, voffB);
            PG8_WAIT_V(6); PG8_BAR; PG8_MMA(1, 1, At, B1); PG8_BAR;
            }
        }
        if constexpr (F8W != 0) asm volatile("s_nop 15\n\ts_nop 15\n\ts_nop 15\n\ts_nop 15" ::: "memory");
        if constexpr (ALIGN_EPI) { if (wr == 0) PG8_BAR; }
        if constexpr (!Epi::AFTER_DRAIN) { E(acc, cur, wr, wc, fr, fq); S.done(cur); }
        if (!has_next) break;
#pragma unroll
        for (int a = 0; a < 2; ++a)
#pragma unroll
            for (int b = 0; b < 2; ++b)
#pragma unroll
                for (int m = 0; m < 4; ++m)
#pragma unroll
                    for (int n = 0; n < 2; ++n) acc[a][b][m][n] = (f32x4){0.f, 0.f, 0.f, 0.f};
        cur = nxt; cA = nA; cB = nB; ++ui;
        if constexpr (GATHER) {
#pragma unroll
            for (int h_ = 0; h_ < 2; ++h_)
#pragma unroll
                for (int i_ = 0; i_ < 2; ++i_) cv[h_][i_] = sv[h_][i_]; }
        if constexpr (ALIGN_EPI) { if (wr == 1) PG8_BAR; }
    }
    PG8_WAIT_V(0);
    if constexpr (!ALIGN_EPI) { if (wr == 0) PG8_BAR; }
    PG8_BAR;
    if constexpr (Epi::AFTER_DRAIN) { E.fused(acc, cur, wr, wc, fr, fq, lds, wid, lane); S.done(cur); }
#undef PG8_SA
#undef PG8_SB
#undef PG8_STAGE
#undef PG8_STAGE_G
#undef PG8_GOFFS
#undef PG8_LDA
#undef PG8_LD1
#undef PG8_LDB
#undef PG8_MMA
#undef PG8_WAIT_V
#undef PG8_WAIT_L
#undef PG8_BAR
#undef PG8_SCHED
}
}

#define XB_TMO      128
#define XB_XCNT(j)  (256  + 64 * (j))
#define XB_XSUB(j)  (1280 + 64 * (j))
#define XB_XGEN(j)  (2304 + 64 * (j))
#define XB_TOP      3328
#define XB_TOPGEN   3392
#define XCD_BAR_WORDS 3456
#define XB_SPIN_CAP (1u << 18)

__device__ __forceinline__ unsigned xb_ld(unsigned* p)              { return __hip_atomic_load(p, __ATOMIC_RELAXED, __HIP_MEMORY_SCOPE_AGENT); }
__device__ __forceinline__ unsigned xb_add(unsigned* p, unsigned v) { return __hip_atomic_fetch_add(p, v, __ATOMIC_RELAXED, __HIP_MEMORY_SCOPE_AGENT); }
__device__ __forceinline__ unsigned xb_xcc_id() { return (unsigned)__builtin_amdgcn_s_getreg((3 << 11) | 20) & 0xFu; }
#define XB_SPIN(cond, bar) do { unsigned _sp = 0; while (cond) { __builtin_amdgcn_s_sleep(1); \
    if ((++_sp & 255u) == 0u) { if (xb_ld(&(bar)[XB_TMO])) break; if (_sp > XB_SPIN_CAP) { atomicAdd(&(bar)[XB_TMO], 1u); break; } } } } while (0)

struct XcdBarrier {
    unsigned* bar; unsigned x;
    volatile LAS unsigned* st;
};

__device__ __forceinline__ XcdBarrier xcd_barrier_post(unsigned* bar, volatile LAS unsigned* st) {
    XcdBarrier b; b.bar = bar; b.x = xb_xcc_id(); b.st = st;
    if (threadIdx.x == 0) (void)xb_add(&bar[XB_XCNT(b.x)], 1u);
    return b;
}
__device__ __forceinline__ void xcd_barrier_complete(unsigned* bar, unsigned x, unsigned& nloc, unsigned& nx) {
    const unsigned G = gridDim.x * gridDim.y * gridDim.z;
    unsigned sum, cnt, mine, sp = 0u;
    for (;;) {
        sum = 0u; cnt = 0u; mine = 0u;
#pragma unroll
        for (unsigned j = 0; j < 16; ++j) { const unsigned c = xb_ld(&bar[XB_XCNT(j)]); sum += c; cnt += (c > 0u) ? 1u : 0u; mine = (j == x) ? c : mine; }
        if (sum == G) break;
        __builtin_amdgcn_s_sleep(1);
        if ((++sp & 255u) == 0u) { if (xb_ld(&bar[XB_TMO])) break; if (sp > XB_SPIN_CAP) { atomicAdd(&bar[XB_TMO], 1u); break; } }
    }
    nloc = mine > 0u ? mine : 1u; nx = cnt > 0u ? cnt : 1u;
}

__device__ __forceinline__ void xcd_barrier(const XcdBarrier& b) {
    asm volatile("s_waitcnt vmcnt(0)" ::: "memory");
    __syncthreads();
    if (threadIdx.x == 0) {
        unsigned* bar = b.bar;
        __builtin_amdgcn_s_waitcnt(0);
        unsigned nloc = b.st[0], nx = b.st[1];
        if (nloc == 0u) { xcd_barrier_complete(bar, b.x, nloc, nx); b.st[0] = nloc; b.st[1] = nx; }
        const unsigned old = xb_add(&bar[XB_XSUB(b.x)], 1u);
        const unsigned gen = old / nloc;
        if (old + 1u == (gen + 1u) * nloc) {
            __builtin_amdgcn_fence(__ATOMIC_RELEASE, "agent");
            asm volatile("s_waitcnt vmcnt(0)" ::: "memory");
            const unsigned og = xb_add(&bar[XB_TOP], 1u);
            const unsigned tg = og / nx;
            if (og + 1u == (tg + 1u) * nx) xb_add(&bar[XB_TOPGEN], 1u);
            else XB_SPIN(xb_ld(&bar[XB_TOPGEN]) == tg, bar);
            __builtin_amdgcn_fence(__ATOMIC_ACQUIRE, "agent");
            xb_add(&bar[XB_XGEN(b.x)], 1u);
            asm volatile("s_waitcnt vmcnt(0)" ::: "memory");
        } else {
            XB_SPIN(xb_ld(&bar[XB_XGEN(b.x)]) == gen, bar);
            __builtin_amdgcn_fence(__ATOMIC_ACQUIRE, "agent");
            asm volatile("s_waitcnt vmcnt(0)" ::: "memory");
        }
    }
    __syncthreads();
}

template <int NT>
__device__ __forceinline__ void rms1_tokens(int t0, int lane, const float* __restrict__ x, const float* __restrict__ nw, const float* __restrict__ w_in,
                                            const float* __restrict__ a_log, const float* __restrict__ dt_bias, bf16* hn, float* beta, float* gl) {
    float4 v[NT][4]; float rs[NT];
#pragma unroll
    for (int u = 0; u < NT; ++u) { const float4* xr = (const float4*)(x + (size_t)(t0 + u) * D); float ss = 0.f;
#pragma unroll
        for (int j = 0; j < 4; ++j) { v[u][j] = xr[lane + 64 * j]; ss += v[u][j].x * v[u][j].x + v[u][j].y * v[u][j].y + v[u][j].z * v[u][j].z + v[u][j].w * v[u][j].w; }
        rs[u] = ss; }
#pragma unroll
    for (int u = 0; u < NT; ++u) rs[u] = rsqrtf(wave_sum(rs[u]) * (1.f / D) + EPS);
    float dots[NT][8];
#pragma unroll
    for (int u = 0; u < NT; ++u)
#pragma unroll
        for (int c = 0; c < 8; ++c) dots[u][c] = 0.f;
#pragma unroll
    for (int j = 0; j < 4; ++j) {
        const int e = 4 * (lane + 64 * j);
        const float4 w = ((const float4*)nw)[lane + 64 * j];
        float h[NT][4];
#pragma unroll
        for (int u = 0; u < NT; ++u) { const float r = rs[u]; h[u][0] = v[u][j].x * r * w.x; h[u][1] = v[u][j].y * r * w.y; h[u][2] = v[u][j].z * r * w.z; h[u][3] = v[u][j].w * r * w.w;
            uint2 o; o.x = pk2(h[u][0], h[u][1]); o.y = pk2(h[u][2], h[u][3]);
            *(uint2*)(hn + (size_t)(t0 + u) * D + e) = o; }
#pragma unroll
        for (int i = 0; i < 4; ++i) {
            const float4* wr = (const float4*)(w_in + (size_t)(e + i) * IN_COLS + OFF_B);
            const float4 w0 = wr[0], w1 = wr[1];
#pragma unroll
            for (int u = 0; u < NT; ++u) { const float hh = h[u][i];
                dots[u][0] += hh * w0.x; dots[u][1] += hh * w0.y; dots[u][2] += hh * w0.z; dots[u][3] += hh * w0.w;
                dots[u][4] += hh * w1.x; dots[u][5] += hh * w1.y; dots[u][6] += hh * w1.z; dots[u][7] += hh * w1.w; }
        }
    }
#pragma unroll
    for (int u = 0; u < NT; ++u) {
#pragma unroll
        for (int c = 0; c < 8; ++c) dots[u][c] = wave_sum(dots[u][c]);
        if (lane < 4) {
            const float d = lane == 0 ? dots[u][0] : lane == 1 ? dots[u][1] : lane == 2 ? dots[u][2] : dots[u][3];
            beta[(t0 + u) * 4 + lane] = sigmoidf_(d);
            const float a = lane == 0 ? dots[u][4] : lane == 1 ? dots[u][5] : lane == 2 ? dots[u][6] : dots[u][7];
            gl[(t0 + u) * 4 + lane] = -__expf(a_log[lane]) * softplusf_(a + dt_bias[lane]);
        }
    }
}

__device__ __forceinline__ float conf_glu(const bf16* proj, int t, int c) {
    const float a = bf2f(proj[(size_t)t * PC + 2048 + c]), g = bf2f(proj[(size_t)t * PC + 2560 + c]);
    return a * sigmoidf_(g);
}
__device__ __forceinline__ void conf_tile(int tile, const bf16* proj, const float* __restrict__ dw, const float* __restrict__ db, const float* __restrict__ lw, const float* __restrict__ lb,
                                          bf16* mix, float* red  ) {
    const int c = threadIdx.x, wave = threadIdx.x >> 6, lane = threadIdx.x & 63;
    const int b = tile / (S / 64), s0 = (tile % (S / 64)) * 64, t0 = b * S + s0;
    float wj[CFK];
#pragma unroll
    for (int j = 0; j < CFK; ++j) wj[j] = dw[j * CF + c];
    const float bias = db[c], lnw = lw[c], lnb = lb[c];
    float win[38];
    unsigned short ra[8], rg[8];
#pragma unroll
    for (int i = 0; i < 8; ++i) { ra[i] = proj[(size_t)(t0 + i) * PC + 2048 + c]; rg[i] = proj[(size_t)(t0 + i) * PC + 2560 + c]; }
#pragma unroll
    for (int i = 0; i < 30; ++i) win[i] = (s0 - 30 + i >= 0) ? conf_glu(proj, t0 - 30 + i, c) : 0.f;
    for (int blk = 0; blk < 8; ++blk) {
#pragma unroll
        for (int i = 0; i < 8; ++i) win[30 + i] = bf2f(ra[i]) * sigmoidf_(bf2f(rg[i]));
        if (blk < 7) {
#pragma unroll
            for (int i = 0; i < 8; ++i) { ra[i] = proj[(size_t)(t0 + blk * 8 + 8 + i) * PC + 2048 + c]; rg[i] = proj[(size_t)(t0 + blk * 8 + 8 + i) * PC + 2560 + c]; }
        }
        float o[8];
#pragma unroll
        for (int i = 0; i < 8; ++i) { float a = bias;
#pragma unroll
            for (int j = 0; j < CFK; ++j) a += wj[j] * win[i + j];
            o[i] = a; }
        float* ob = red; float* st = red + 8 * CF;
#pragma unroll
        for (int i = 0; i < 8; ++i) ob[i * CF + c] = o[i];
        __syncthreads();
        { float s1 = 0.f, s2 = 0.f;
#pragma unroll
          for (int k = 0; k < 8; ++k) { const float v = ob[wave * CF + lane + 64 * k]; s1 += v; s2 += v * v; }
          s1 = wave_sum(s1); s2 = wave_sum(s2);
          if (lane == 0) { const float mu = s1 * (1.f / CF), var = fmaxf(s2 * (1.f / CF) - mu * mu, 0.f); st[2 * wave] = mu; st[2 * wave + 1] = rsqrtf(var + EPS); } }
        __syncthreads();
#pragma unroll
        for (int i = 0; i < 8; ++i) {
            const float y = (o[i] - st[2 * i]) * st[2 * i + 1] * lnw + lnb;
            mix[(size_t)(t0 + blk * 8 + i) * D + 512 + c] = (bf16)f2bf(siluf_(y));
        }
#pragma unroll
        for (int i = 0; i < 30; ++i) win[i] = win[i + 8];
    }
    __syncthreads();
}

typedef short bf16x8 __attribute__((ext_vector_type(8)));
typedef float f32x4 __attribute__((ext_vector_type(4)));
typedef unsigned u32x2 __attribute__((ext_vector_type(2)));
__device__ __forceinline__ f32x4 mfma16(bf16x8 a, bf16x8 b, f32x4 c) { return __builtin_amdgcn_mfma_f32_16x16x32_bf16(a, b, c, 0, 0, 0); }
__device__ __forceinline__ bf16x8 as_bf16x8(v4u v) { return __builtin_bit_cast(bf16x8, v); }
__device__ __forceinline__ void rms2_group(int grp, const bf16* xmid, const float* __restrict__ nw, const v4u* wrh, const v4u* wrl, const float* __restrict__ br, unsigned char* xn, int* tope, float* topg, int* ghist, unsigned char* sm) {
    float* rr = (float*)sm; float* lg = (float*)(sm + 256); int* lhist = (int*)(sm + 8704);
    const int tid = threadIdx.x, wave = __builtin_amdgcn_readfirstlane(tid >> 6), lane = tid & 63, tb = grp * 64;
    if (tid < NE) lhist[tid] = 0;
    {
        uint4 xa[8], xb[8];
#pragma unroll
        for (int i = 0; i < 8; ++i) { const uint4* xr = (const uint4*)(xmid + (size_t)(tb + 8 * wave + i) * D + 16 * lane); xa[i] = xr[0]; xb[i] = xr[1]; }
        float4 w4[4];
#pragma unroll
        for (int j = 0; j < 4; ++j) w4[j] = ((const float4*)(nw + 16 * lane))[j];
#pragma unroll
        for (int i = 0; i < 8; ++i) {
            const uint4 a = xa[i], b = xb[i];
            float v[16] = {bf2f(a.x & 0xffffu), bf2f(a.x >> 16), bf2f(a.y & 0xffffu), bf2f(a.y >> 16), bf2f(a.z & 0xffffu), bf2f(a.z >> 16), bf2f(a.w & 0xffffu), bf2f(a.w >> 16),
                           bf2f(b.x & 0xffffu), bf2f(b.x >> 16), bf2f(b.y & 0xffffu), bf2f(b.y >> 16), bf2f(b.z & 0xffffu), bf2f(b.z >> 16), bf2f(b.w & 0xffffu), bf2f(b.w >> 16)};
            float ss = 0.f;
#pragma unroll
            for (int j = 0; j < 16; ++j) ss += v[j] * v[j];
            const float r = rsqrtf(wave_sum(ss) * (1.f / D) + EPS);
            if (lane == 0) rr[8 * wave + i] = r;
            int o[4];
#pragma unroll
            for (int j = 0; j < 4; ++j) { const float4 w = w4[j];
                int p = 0; p = __builtin_amdgcn_cvt_pk_fp8_f32(v[4 * j] * r * w.x, v[4 * j + 1] * r * w.y, p, false); p = __builtin_amdgcn_cvt_pk_fp8_f32(v[4 * j + 2] * r * w.z, v[4 * j + 3] * r * w.w, p, true); o[j] = p; }
            *(int4*)(xn + (size_t)(tb + 8 * wave + i) * D + 16 * lane) = make_int4(o[0], o[1], o[2], o[3]);
        }
    }
    {
        const int r = lane & 15, q = lane >> 4, tt = wave >> 1, nt = wave & 1;
        const bf16* xrow = xmid + (size_t)(tb + 16 * tt + r) * D + 8 * q;
        f32x4 acc = (f32x4){0.f, 0.f, 0.f, 0.f};
#pragma unroll 1
        for (int k8 = 0; k8 < 32; k8 += 8) {
            v4u av[8], bh[8], bl[8];
#pragma unroll
            for (int u = 0; u < 8; ++u) { av[u] = *(const v4u*)(xrow + 32 * (k8 + u)); bh[u] = wrh[((k8 + u) * 2 + nt) * 64 + lane]; bl[u] = wrl[((k8 + u) * 2 + nt) * 64 + lane]; }
#pragma unroll
            for (int u = 0; u < 8; ++u) { acc = mfma16(as_bf16x8(av[u]), as_bf16x8(bh[u]), acc); acc = mfma16(as_bf16x8(av[u]), as_bf16x8(bl[u]), acc); }
        }
        __syncthreads();
        const float bb = br[16 * nt + r];
#pragma unroll
        for (int ii = 0; ii < 4; ++ii) { const int tok = 16 * tt + 4 * q + ii; lg[tok * 33 + 16 * nt + r] = acc[ii] * rr[tok] + bb; }
    }
    __syncthreads();
    if (tid < 64) {
        const float* l = lg + tid * 33;
        int ti[4]; float tv[4];
#pragma unroll
        for (int k = 0; k < 4; ++k) {
            float best = -INFINITY; int bi = 0;
            for (int x = 0; x < NE; ++x) { const bool taken = (k > 0 && ti[0] == x) || (k > 1 && ti[1] == x) || (k > 2 && ti[2] == x); const float v = l[x]; if (!taken && v > best) { best = v; bi = x; } }
            ti[k] = bi; tv[k] = best;
        }
        const float e1 = __expf(tv[1] - tv[0]), e2 = __expf(tv[2] - tv[0]), e3 = __expf(tv[3] - tv[0]);
        const float inv = 1.f / (1.f + e1 + e2 + e3);
        const int t = tb + tid;
        *(int4*)(tope + t * 4) = make_int4(ti[0], ti[1], ti[2], ti[3]);
        *(float4*)(topg + t * 4) = make_float4(inv, e1 * inv, e2 * inv, e3 * inv);
        atomicAdd(&lhist[ti[0]], 1); atomicAdd(&lhist[ti[1]], 1); atomicAdd(&lhist[ti[2]], 1); atomicAdd(&lhist[ti[3]], 1);
    }
    __syncthreads();
    if (tid < NE) ghist[grp * NE + tid] = lhist[tid];
    __syncthreads();
}

__device__ __forceinline__ void route_group(int grp, const int* ghist, const int* tope, const float* topg, int* rowtok, int* pos, float* rgate, int* blke, int* sm) {
    int* ptot = sm; int* ppre = sm + 512; int* tot = sm + 1024; int* pre = tot + 32; int* base = pre + 32; int* pe = base + 32; int* ppos = pe + 256;
    const int tid = threadIdx.x, nth = blockDim.x;
    if (tid < 256) pe[tid] = tope[grp * 256 + tid];
    { const int e = tid & 31, part = tid >> 5; int a = 0, p = 0;
#pragma unroll 4
      for (int w = part * 16; w < part * 16 + 16; ++w) { const int v = ghist[w * NE + e]; a += v; if (w < grp) p += v; }
      ptot[part * 32 + e] = a; ppre[part * 32 + e] = p; }
    __syncthreads();
    if (tid < NE) { int a = 0, p = 0;
#pragma unroll
        for (int part = 0; part < 16; ++part) { a += ptot[part * 32 + tid]; p += ppre[part * 32 + tid]; }
        tot[tid] = a; pre[tid] = p; }
    __syncthreads();
    if (tid == 0) {
        int blk = 0;
        for (int e = 0; e < NE; ++e) { base[e] = blk * RB; const int nb = (tot[e] + RB - 1) / RB; if (grp == 0) for (int q = 0; q < nb; ++q) blke[blk + q] = e; blk += nb; }
        if (grp == 0) blke[MAXBLK] = blk;
    }
    __syncthreads();
    if (tid < 256) {
        const int e = pe[tid]; int rank = 0;
        for (int p = 0; p < tid; ++p) rank += (pe[p] == e) ? 1 : 0;
        const int pp = base[e] + pre[e] + rank;
        ppos[tid] = pp; pos[grp * 256 + tid] = pp; rgate[pp] = topg[grp * 256 + tid]; rowtok[pp] = grp * 64 + (tid >> 2);
    }
    __syncthreads();
    if (grp < NE) {
        const int e = grp, r0 = base[e] + tot[e], r1 = base[e] + ((tot[e] + RB - 1) / RB) * RB;
        for (int r = r0 + tid; r < r1; r += nth) { rowtok[r] = T; rgate[r] = 0.f; }
    }
    __syncthreads();
}

__device__ __forceinline__ void combine_token(int t, int lane, const bf16* xmid, const unsigned char* y, const int* pos, const float* __restrict__ fw, float* out) {
    const uint2* xr = (const uint2*)(xmid + (size_t)t * D);
    const int4 pp = *(const int4*)(pos + t * 4);
    const int pr[4] = {pp.x, pp.y, pp.z, pp.w};
    float4 v[4]; float ss = 0.f;
#pragma unroll
    for (int j = 0; j < 4; ++j) {
        { const uint2 xx = xr[lane + 64 * j]; v[j] = make_float4(bf2f(xx.x & 0xffffu), bf2f(xx.x >> 16), bf2f(xx.y & 0xffffu), bf2f(xx.y >> 16)); }
#pragma unroll
        for (int k = 0; k < 4; ++k) { const int q = *(const int*)(y + (size_t)pr[k] * D + 4 * (lane + 64 * j));
            typedef float f32x2_ __attribute__((ext_vector_type(2)));
            const f32x2_ lo = __builtin_amdgcn_cvt_pk_f32_fp8(q, false), hi = __builtin_amdgcn_cvt_pk_f32_fp8(q, true);
            v[j].x += lo[0] * 0.0625f; v[j].y += lo[1] * 0.0625f; v[j].z += hi[0] * 0.0625f; v[j].w += hi[1] * 0.0625f; }
        ss += v[j].x * v[j].x + v[j].y * v[j].y + v[j].z * v[j].z + v[j].w * v[j].w;
    }
    const float r = rsqrtf(wave_sum(ss) * (1.f / D) + EPS);
#pragma unroll
    for (int j = 0; j < 4; ++j) { const float4 w = ((const float4*)fw)[lane + 64 * j];
        ((float4*)(out + (size_t)t * D))[lane + 64 * j] = make_float4(v[j].x * r * w.x, v[j].y * r * w.y, v[j].z * r * w.z, v[j].w * r * w.w); }
}

constexpr int GP_KN = 0, GP_QN = 17408, GP_VC = 34816, GP_AM = 52224, GP_IM = 69632, GP_UT = 78848, GP_WT = 97280, GP_KT = 115712, GP_GC = 134144, GP_BT = 134400, GP_TI = 134656, GP_END = 143872;
static_assert(GP_WT == GP_UT + 128 * 144, "uT and wT must be contiguous");
constexpr int AMS = 68;
constexpr int RS = 272, TS = 144;

__device__ __forceinline__ void gdn_prep_task(int task, LAS unsigned char* L, const bf16* proj, const float* __restrict__ cw, const float* beta, const float* gl,
                                              v4u* Pf, v4u* Qc, v4u* RTf, u32x2* O0c) {
    const int tid = threadIdx.x, lane = tid & 63, wave = __builtin_amdgcn_readfirstlane(tid >> 6), r = lane & 15, q = lane >> 4;
    const int bh = task >> 7, n = task & 127, b = bh >> 2, h = bh & 3, s0 = n * 64, t0 = b * S + s0;
    LAS float* gcs = (LAS float*)(L + GP_GC); LAS float* bts = (LAS float*)(L + GP_BT);
    {
        float g = gl[(t0 + lane) * 4 + h];
#pragma unroll
        for (int o = 1; o < 64; o <<= 1) { const float v = __shfl_up(g, o); if (lane >= o) g += v; }
        const float bt = beta[(t0 + lane) * 4 + h];
        if (wave == 0) { gcs[lane] = g; bts[lane] = bt; }
        const int i0 = 8 * wave, cb = h * 128 + 2 * lane;
        float wq[4][2], wk[4][2], wv[4][2];
#pragma unroll
        for (int j = 0; j < 4; ++j) { const float2 a = *(const float2*)(cw + j * 1536 + cb), bb = *(const float2*)(cw + j * 1536 + 512 + cb), c = *(const float2*)(cw + j * 1536 + 1024 + cb);
            wq[j][0] = a.x; wq[j][1] = a.y; wk[j][0] = bb.x; wk[j][1] = bb.y; wv[j][0] = c.x; wv[j][1] = c.y; }
        unsigned rq[11], rk[11], rv[11];
#pragma unroll
        for (int rho = 0; rho < 11; ++rho) {
            const int s = s0 + i0 - 3 + rho;
            if (s >= 0) { const bf16* p = proj + (size_t)(t0 + i0 - 3 + rho) * PC + cb; rq[rho] = *(const unsigned*)p; rk[rho] = *(const unsigned*)(p + 512); rv[rho] = *(const unsigned*)(p + 1024); }
            else { rq[rho] = 0u; rk[rho] = 0u; rv[rho] = 0u; }
        }
#pragma unroll
        for (int ii = 0; ii < 8; ++ii) {
            float q0 = 0.f, q1 = 0.f, k0 = 0.f, k1 = 0.f, v0 = 0.f, v1 = 0.f;
#pragma unroll
            for (int j = 0; j < 4; ++j) {
                q0 += wq[j][0] * bf2f(rq[ii + j] & 0xffffu); q1 += wq[j][1] * bf2f(rq[ii + j] >> 16);
                k0 += wk[j][0] * bf2f(rk[ii + j] & 0xffffu); k1 += wk[j][1] * bf2f(rk[ii + j] >> 16);
                v0 += wv[j][0] * bf2f(rv[ii + j] & 0xffffu); v1 += wv[j][1] * bf2f(rv[ii + j] >> 16);
            }
            q0 = siluf_(q0); q1 = siluf_(q1); k0 = siluf_(k0); k1 = siluf_(k1); v0 = siluf_(v0); v1 = siluf_(v1);
            const float sq = rsqrtf(wave_sum(q0 * q0 + q1 * q1) + EPS) * 0.08838834764831845f, sk = rsqrtf(wave_sum(k0 * k0 + k1 * k1) + EPS);
            const int ro = (i0 + ii) * RS + 4 * lane;
            *(LAS unsigned*)(L + GP_QN + ro) = pk2(q0 * sq, q1 * sq);
            *(LAS unsigned*)(L + GP_KN + ro) = pk2(k0 * sk, k1 * sk);
            *(LAS unsigned*)(L + GP_VC + ro) = pk2(v0, v1);
        }
    }
    __syncthreads();
    {
        const int ti = wave >> 1, tj0 = (wave & 1) * 2;
        f32x4 kk[2], qk[2];
#pragma unroll
        for (int u = 0; u < 2; ++u) { kk[u] = (f32x4){0.f, 0.f, 0.f, 0.f}; qk[u] = (f32x4){0.f, 0.f, 0.f, 0.f}; }
#pragma unroll
        for (int s = 0; s < 4; ++s) {
            const int co = (32 * s + 8 * q) * 2;
            const bf16x8 ak = *(const LAS bf16x8*)(L + GP_KN + (16 * ti + r) * RS + co), aq = *(const LAS bf16x8*)(L + GP_QN + (16 * ti + r) * RS + co);
#pragma unroll
            for (int u = 0; u < 2; ++u) { const bf16x8 bk = *(const LAS bf16x8*)(L + GP_KN + (16 * (tj0 + u) + r) * RS + co); kk[u] = mfma16(ak, bk, kk[u]); qk[u] = mfma16(aq, bk, qk[u]); }
        }
#pragma unroll
        for (int u = 0; u < 2; ++u) {
            const int j = 16 * (tj0 + u) + r; const float gcj = gcs[j];
#pragma unroll
            for (int ii = 0; ii < 4; ++ii) {
                const int i = 16 * ti + 4 * q + ii; const float gci = gcs[i], bti = bts[i];
                const float dec = (i >= j) ? __expf(gci - gcj) : 0.f;
                *(LAS float*)(L + GP_AM + (i * AMS + j) * 4) = (i > j) ? bti * kk[u][ii] * dec : 0.f;
                *(LAS unsigned short*)(L + GP_IM + i * TS + j * 2) = (unsigned short)f2bf(qk[u][ii] * dec);
            }
        }
    }
    __syncthreads();
    {
        float Ac[64];
#pragma unroll
        for (int j4 = 0; j4 < 64; j4 += 4) { const f32x4 av = *(const LAS f32x4*)(L + GP_AM + (lane * AMS + j4) * 4); Ac[j4] = av[0]; Ac[j4 + 1] = av[1]; Ac[j4 + 2] = av[2]; Ac[j4 + 3] = av[3]; }
        const float bti = bts[lane], gci = gcs[lane], ekt = __expf(gcs[63] - gci), ew = bti * __expf(gci);
        const int ca = 4 * wave, cb2 = 60 - 4 * wave;
        float xa[4], xb[4];
#pragma unroll
        for (int c = 0; c < 4; ++c) { xa[c] = (lane == ca + c) ? 1.f : 0.f; xb[c] = (lane == cb2 + c) ? 1.f : 0.f; }
#pragma unroll
        for (int jc = 0; jc < 8; ++jc) {
            if (8 * jc + 7 >= ca) {
#pragma unroll
                for (int jj = 0; jj < 8; ++jj) { const int j = 8 * jc + jj; if (j < 63) {
#pragma unroll
                    for (int c = 0; c < 4; ++c) { const float xj = __builtin_bit_cast(float, __builtin_amdgcn_readlane(__builtin_bit_cast(int, xa[c]), j)); xa[c] -= Ac[j] * xj; } } }
            }
            if (8 * jc + 7 >= cb2) {
#pragma unroll
                for (int jj = 0; jj < 8; ++jj) { const int j = 8 * jc + jj; if (j < 63) {
#pragma unroll
                    for (int c = 0; c < 4; ++c) { const float xj = __builtin_bit_cast(float, __builtin_amdgcn_readlane(__builtin_bit_cast(int, xb[c]), j)); xb[c] -= Ac[j] * xj; } } }
            }
        }
        { u32x2 o; o.x = pk2(xa[0], xa[1]); o.y = pk2(xa[2], xa[3]); *(LAS u32x2*)(L + GP_TI + lane * TS + ca * 2) = o;
          o.x = pk2(xb[0], xb[1]); o.y = pk2(xb[2], xb[3]); *(LAS u32x2*)(L + GP_TI + lane * TS + cb2 * 2) = o; }
#pragma unroll 1
        for (int gi = 0; gi < 4; ++gi) {
            const int cg = wave * 4 + gi, col0 = 8 * cg;
            const bool isw = col0 >= 128; const int cc = isw ? col0 - 128 : col0;
            const v4u raw = *(const LAS v4u*)(L + (isw ? GP_KN : GP_VC) + lane * RS + cc * 2);
            const float sc = isw ? ew : bti;
            const float x[8] = {bf2f(raw.x & 0xffffu) * sc, bf2f(raw.x >> 16) * sc, bf2f(raw.y & 0xffffu) * sc, bf2f(raw.y >> 16) * sc,
                                bf2f(raw.z & 0xffffu) * sc, bf2f(raw.z >> 16) * sc, bf2f(raw.w & 0xffffu) * sc, bf2f(raw.w >> 16) * sc};
            LAS unsigned char* dst = L + (isw ? GP_WT : GP_UT) + cc * TS + lane * 2;
#pragma unroll
            for (int c = 0; c < 8; ++c) *(LAS unsigned short*)(dst + c * TS) = (unsigned short)f2bf(x[c]);
        }
#pragma unroll 1
        for (int gi = 0; gi < 2; ++gi) {
            const int d0 = 8 * (wave * 2 + gi);
            const v4u raw = *(const LAS v4u*)(L + GP_KN + lane * RS + d0 * 2);
            const float x[8] = {bf2f(raw.x & 0xffffu) * ekt, bf2f(raw.x >> 16) * ekt, bf2f(raw.y & 0xffffu) * ekt, bf2f(raw.y >> 16) * ekt,
                                bf2f(raw.z & 0xffffu) * ekt, bf2f(raw.z >> 16) * ekt, bf2f(raw.w & 0xffffu) * ekt, bf2f(raw.w >> 16) * ekt};
            LAS unsigned char* dst = L + GP_KT + d0 * TS + lane * 2;
#pragma unroll
            for (int c = 0; c < 8; ++c) *(LAS unsigned short*)(dst + c * TS) = (unsigned short)f2bf(x[c]);
        }
    }
    __syncthreads();
    {
        const int co0 = (8 * q) * 2, co1 = (32 + 8 * q) * 2;
        bf16x8 tb0[4], tb1[4];
#pragma unroll
        for (int tn = 0; tn < 4; ++tn) { tb0[tn] = *(const LAS bf16x8*)(L + GP_TI + (16 * tn + r) * TS + co0); tb1[tn] = *(const LAS bf16x8*)(L + GP_TI + (16 * tn + r) * TS + co1); }
#pragma unroll
        for (int u = 0; u < 2; ++u) {
            LAS unsigned char* rows = L + GP_UT + (16 * (2 * wave + u)) * TS;
            const bf16x8 a0 = *(const LAS bf16x8*)(rows + r * TS + co0), a1 = *(const LAS bf16x8*)(rows + r * TS + co1);
            f32x4 cc[4];
#pragma unroll
            for (int tn = 0; tn < 4; ++tn) { cc[tn] = (f32x4){0.f, 0.f, 0.f, 0.f}; cc[tn] = mfma16(a0, tb0[tn], cc[tn]); cc[tn] = mfma16(a1, tb1[tn], cc[tn]); }
#pragma unroll
            for (int tn = 0; tn < 4; ++tn)
#pragma unroll
                for (int ii = 0; ii < 4; ++ii) *(LAS unsigned short*)(rows + (4 * q + ii) * TS + (16 * tn + r) * 2) = (unsigned short)f2bf(cc[tn][ii]);
        }
    }
    __syncthreads();
    {
        const float gtot = __expf(gcs[63]);
        const int co0 = (8 * q) * 2, co1 = (32 + 8 * q) * 2;
        {
            const bf16x8 b0 = *(const LAS bf16x8*)(L + GP_KT + (16 * wave + r) * TS + co0), b1 = *(const LAS bf16x8*)(L + GP_KT + (16 * wave + r) * TS + co1);
#pragma unroll
            for (int s = 0; s < 4; ++s) {
                const LAS unsigned char* a0p = L + GP_WT + (32 * s + r) * TS; const LAS unsigned char* a1p = a0p + 16 * TS;
                f32x4 c0 = (f32x4){0.f, 0.f, 0.f, 0.f}, c1 = c0;
                c0 = mfma16(*(const LAS bf16x8*)(a0p + co0), b0, c0); c0 = mfma16(*(const LAS bf16x8*)(a0p + co1), b1, c0);
                c1 = mfma16(*(const LAS bf16x8*)(a1p + co0), b0, c1); c1 = mfma16(*(const LAS bf16x8*)(a1p + co1), b1, c1);
                float v0[4], v1[4];
#pragma unroll
                for (int ii = 0; ii < 4; ++ii) { v0[ii] = ((2 * s == wave && 4 * q + ii == r) ? gtot : 0.f) - c0[ii]; v1[ii] = ((2 * s + 1 == wave && 4 * q + ii == r) ? gtot : 0.f) - c1[ii]; }
                v4u o; o.x = pk2(v0[0], v0[1]); o.y = pk2(v0[2], v0[3]); o.z = pk2(v1[0], v1[1]); o.w = pk2(v1[2], v1[3]);
                Pf[((size_t)(task * 8 + wave) * 4 + s) * 64 + lane] = o;
            }
        }
        {
            const bf16x8 b0 = *(const LAS bf16x8*)(L + GP_UT + (16 * wave + r) * TS + co0), b1 = *(const LAS bf16x8*)(L + GP_UT + (16 * wave + r) * TS + co1);
#pragma unroll
            for (int tp = 0; tp < 4; ++tp) {
                const LAS unsigned char* ap = L + GP_KT + (32 * tp + r) * TS; const LAS unsigned char* ap2 = ap + 16 * TS;
                f32x4 c = (f32x4){0.f, 0.f, 0.f, 0.f}, c2 = c;
                c = mfma16(*(const LAS bf16x8*)(ap + co0), b0, c); c = mfma16(*(const LAS bf16x8*)(ap + co1), b1, c);
                c2 = mfma16(*(const LAS bf16x8*)(ap2 + co0), b0, c2); c2 = mfma16(*(const LAS bf16x8*)(ap2 + co1), b1, c2);
                v4u o; o.x = pk2(c[0], c[1]); o.y = pk2(c[2], c[3]); o.z = pk2(c2[0], c2[1]); o.w = pk2(c2[2], c2[3]);
                Qc[((size_t)(task * 8 + wave) * 4 + tp) * 64 + lane] = o;
            }
        }
        {
            const int tn = wave & 3, i = 16 * tn + r; const float egi = __expf(gcs[i]);
            const bf16x8 b0 = *(const LAS bf16x8*)(L + GP_IM + i * TS + co0), b1 = *(const LAS bf16x8*)(L + GP_IM + i * TS + co1);
#pragma unroll
            for (int sx = 0; sx < 2; ++sx) {
                const int s = 2 * (wave >> 2) + sx;
                const LAS unsigned char* a0p = L + GP_WT + (32 * s + r) * TS; const LAS unsigned char* a1p = a0p + 16 * TS;
                f32x4 c0 = (f32x4){0.f, 0.f, 0.f, 0.f}, c1 = c0;
                c0 = mfma16(*(const LAS bf16x8*)(a0p + co0), b0, c0); c0 = mfma16(*(const LAS bf16x8*)(a0p + co1), b1, c0);
                c1 = mfma16(*(const LAS bf16x8*)(a1p + co0), b0, c1); c1 = mfma16(*(const LAS bf16x8*)(a1p + co1), b1, c1);
                const u32x2 q0 = *(const LAS u32x2*)(L + GP_QN + i * RS + (32 * s + 4 * q) * 2), q1 = *(const LAS u32x2*)(L + GP_QN + i * RS + (32 * s + 16 + 4 * q) * 2);
                v4u o;
                o.x = pk2(bf2f(q0.x & 0xffffu) * egi - c0[0], bf2f(q0.x >> 16) * egi - c0[1]); o.y = pk2(bf2f(q0.y & 0xffffu) * egi - c0[2], bf2f(q0.y >> 16) * egi - c0[3]);
                o.z = pk2(bf2f(q1.x & 0xffffu) * egi - c1[0], bf2f(q1.x >> 16) * egi - c1[1]); o.w = pk2(bf2f(q1.y & 0xffffu) * egi - c1[2], bf2f(q1.y >> 16) * egi - c1[3]);
                RTf[((size_t)(task * 4 + tn) * 4 + s) * 64 + lane] = o;
            }
        }
        {
            const bf16x8 a0 = *(const LAS bf16x8*)(L + GP_UT + (16 * wave + r) * TS + co0), a1 = *(const LAS bf16x8*)(L + GP_UT + (16 * wave + r) * TS + co1);
#pragma unroll
            for (int tn = 0; tn < 4; ++tn) {
                const LAS unsigned char* bp = L + GP_IM + (16 * tn + r) * TS;
                f32x4 c = (f32x4){0.f, 0.f, 0.f, 0.f};
                c = mfma16(a0, *(const LAS bf16x8*)(bp + co0), c); c = mfma16(a1, *(const LAS bf16x8*)(bp + co1), c);
                O0c[((size_t)(task * 8 + wave) * 4 + tn) * 64 + lane] = (u32x2){pk2(c[0], c[1]), pk2(c[2], c[3])};
            }
        }
    }
    __syncthreads();
}

constexpr int CH_SLOT = 36864, CH_FLAGS = 3 * CH_SLOT;
__device__ __forceinline__ void ch_spin(volatile LAS int* w, int want) {
    unsigned sp = 0; while (*w < want) { __builtin_amdgcn_s_sleep(1); if (++sp > (1u << 22)) break; }
    asm volatile("" ::: "memory");
}
__device__ __forceinline__ void gdn_chain_loader(int lw, int bh, int c, int lane, LAS unsigned char* L, const v4u* Pf, const v4u* Qc) {
    volatile LAS int* FL = (volatile LAS int*)(L + CH_FLAGS);
    const int sl = lw >> 1, hf = lw & 1;
    LAS unsigned char* slot = L + sl * CH_SLOT;
    for (int m = sl; m < 128; m += 3) {
        if (m >= 3) ch_spin(FL + 8 + sl, m - 2);
        const int task = bh * 128 + m;
        const v4u* ps = Pf + (size_t)task * 2048 + hf * 1024 + lane; const v4u* qs = Qc + (size_t)(task * 8 + c) * 256 + hf * 128 + lane;
#pragma unroll
        for (int f = 0; f < 16; ++f) __builtin_amdgcn_global_load_lds((const unsigned*)(ps + f * 64), (LAS unsigned*)(slot + (16 * hf + f) * 1024), 16, 0, 0);
#pragma unroll
        for (int f = 0; f < 2; ++f) __builtin_amdgcn_global_load_lds((const unsigned*)(qs + f * 64), (LAS unsigned*)(slot + 32768 + (2 * hf + f) * 1024), 16, 0, 0);
        asm volatile("s_waitcnt vmcnt(0)" ::: "memory");
        if (lane == 0) FL[lw] = m + 1;
    }
}
__device__ __forceinline__ unsigned cvtpk(float lo, float hi) { unsigned r; asm volatile("v_cvt_pk_bf16_f32 %0, %1, %2" : "=v"(r) : "v"(lo), "v"(hi)); return r; }
__device__ __forceinline__ void gdn_chain_consumer(int bh, int c, int lane, LAS unsigned char* L, v4u* Sf_, unsigned* prog) {
    volatile LAS int* FL = (volatile LAS int*)(L + CH_FLAGS);
    const __amdgpu_buffer_rsrc_t srs = __builtin_amdgcn_make_buffer_rsrc((void*)Sf_, (short)0, 32 << 20, 0x00020000);
    f32x4 acc[8];
#pragma unroll
    for (int t = 0; t < 8; ++t) acc[t] = (f32x4){0.f, 0.f, 0.f, 0.f};
    int sl = 0;
    for (int n = 0; n < 128; ++n) {
        const int task = bh * 128 + n;
        v4u sf[4];
#pragma unroll
        for (int s = 0; s < 4; ++s) { sf[s].x = cvtpk(acc[2 * s][0], acc[2 * s][1]); sf[s].y = cvtpk(acc[2 * s][2], acc[2 * s][3]); sf[s].z = cvtpk(acc[2 * s + 1][0], acc[2 * s + 1][1]); sf[s].w = cvtpk(acc[2 * s + 1][2], acc[2 * s + 1][3]);
            __builtin_amdgcn_raw_buffer_store_b128(sf[s], srs, (int)((((task * 8 + c) * 4 + s) * 64 + lane) * 16), 0, 16); }
        if (n == 127) break;
        ch_spin(FL + 2 * sl, n + 1); ch_spin(FL + 2 * sl + 1, n + 1);
        const LAS unsigned char* slot = L + sl * CH_SLOT + lane * 16;
        v4u qa, pa[8], qb, pb[8];
        qa = *(const LAS v4u*)(slot + 32768);
#pragma unroll
        for (int f = 0; f < 8; ++f) pa[f] = *(const LAS v4u*)(slot + f * 1024);
#pragma unroll
        for (int tp = 0; tp < 4; tp += 2) {
            qb = *(const LAS v4u*)(slot + 32768 + (tp + 1) * 1024);
#pragma unroll
            for (int f = 0; f < 8; ++f) pb[f] = *(const LAS v4u*)(slot + (8 * (tp + 1) + f) * 1024);
            __builtin_amdgcn_sched_barrier(0);
            { f32x4 a0 = (f32x4){bf2f(qa.x & 0xffffu), bf2f(qa.x >> 16), bf2f(qa.y & 0xffffu), bf2f(qa.y >> 16)}, a1 = (f32x4){bf2f(qa.z & 0xffffu), bf2f(qa.z >> 16), bf2f(qa.w & 0xffffu), bf2f(qa.w >> 16)};
#pragma unroll
              for (int s = 0; s < 4; ++s) { a0 = mfma16(as_bf16x8(pa[s]), as_bf16x8(sf[s]), a0); a1 = mfma16(as_bf16x8(pa[4 + s]), as_bf16x8(sf[s]), a1); }
              acc[2 * tp] = a0; acc[2 * tp + 1] = a1; }
            __builtin_amdgcn_sched_barrier(0);
            if (tp + 2 < 4) { qa = *(const LAS v4u*)(slot + 32768 + (tp + 2) * 1024);
#pragma unroll
                for (int f = 0; f < 8; ++f) pa[f] = *(const LAS v4u*)(slot + (8 * (tp + 2) + f) * 1024); }
            __builtin_amdgcn_sched_barrier(0);
            { f32x4 a0 = (f32x4){bf2f(qb.x & 0xffffu), bf2f(qb.x >> 16), bf2f(qb.y & 0xffffu), bf2f(qb.y >> 16)}, a1 = (f32x4){bf2f(qb.z & 0xffffu), bf2f(qb.z >> 16), bf2f(qb.w & 0xffffu), bf2f(qb.w >> 16)};
#pragma unroll
              for (int s = 0; s < 4; ++s) { a0 = mfma16(as_bf16x8(pb[s]), as_bf16x8(sf[s]), a0); a1 = mfma16(as_bf16x8(pb[4 + s]), as_bf16x8(sf[s]), a1); }
              acc[2 * tp + 2] = a0; acc[2 * tp + 3] = a1; }
            __builtin_amdgcn_sched_barrier(0);
        }
        asm volatile("s_waitcnt vmcnt(4) lgkmcnt(0)" ::: "memory");
        if (lane == 0) { FL[8 + sl] = n + 1; __hip_atomic_store(prog, (unsigned)n, __ATOMIC_RELAXED, __HIP_MEMORY_SCOPE_AGENT); }
        sl = (sl == 2) ? 0 : sl + 1;
    }
    asm volatile("s_waitcnt vmcnt(0)" ::: "memory");
    if (lane == 0) __hip_atomic_store(prog, 128u, __ATOMIC_RELAXED, __HIP_MEMORY_SCOPE_AGENT);
}

__device__ __forceinline__ void gdn_out_wave(int task, int tn, int lane, const v4u* Sf, const v4u* RTf, const u32x2* O0c, const bf16* proj, const float* __restrict__ nw, bf16* mix) {
    const int r = lane & 15, q = lane >> 4, bh = task >> 7, n = task & 127, b = bh >> 2, h = bh & 3;
    bf16x8 bfr[4];
#pragma unroll
    for (int s = 0; s < 4; ++s) bfr[s] = as_bf16x8(RTf[((size_t)(task * 4 + tn) * 4 + s) * 64 + lane]);
    f32x4 o[8]; float ss = 0.f;
    v4u sfr[8][4];
#pragma unroll
    for (int c = 0; c < 8; ++c) { const u32x2 ov = O0c[((size_t)(task * 8 + c) * 4 + tn) * 64 + lane]; o[c] = (f32x4){bf2f(ov.x & 0xffffu), bf2f(ov.x >> 16), bf2f(ov.y & 0xffffu), bf2f(ov.y >> 16)};
#pragma unroll
        for (int s = 0; s < 4; ++s) sfr[c][s] = Sf[((size_t)(task * 8 + c) * 4 + s) * 64 + lane]; }
    const size_t t = (size_t)b * S + n * 64 + 16 * tn + r;
    uint2 zz[8];
#pragma unroll
    for (int c = 0; c < 8; ++c) zz[c] = *(const uint2*)(proj + t * PC + 1536 + h * 128 + 16 * c + 4 * q);
    __builtin_amdgcn_sched_barrier(0);
#pragma unroll
    for (int c = 0; c < 8; ++c) {
        f32x4 a = o[c];
#pragma unroll
        for (int s = 0; s < 4; ++s) a = mfma16(as_bf16x8(sfr[c][s]), bfr[s], a);
        o[c] = a; ss += (a[0] * a[0] + a[1] * a[1]) + (a[2] * a[2] + a[3] * a[3]);
    }
    ss += __shfl_xor(ss, 16); ss += __shfl_xor(ss, 32);
    const float rr = rsqrtf(ss * (1.f / 128.f) + EPS);
#pragma unroll
    for (int c = 0; c < 8; ++c) {
        const int dv0 = 16 * c + 4 * q;
        const uint2 z = zz[c]; const float4 w = *(const float4*)(nw + dv0);
        uint2 y; y.x = pk2(o[c][0] * rr * w.x * siluf_(bf2f(z.x & 0xffffu)), o[c][1] * rr * w.y * siluf_(bf2f(z.x >> 16)));
        y.y = pk2(o[c][2] * rr * w.z * siluf_(bf2f(z.y & 0xffffu)), o[c][3] * rr * w.w * siluf_(bf2f(z.y >> 16)));
        *(uint2*)(mix + t * D + h * 128 + dv0) = y;
    }
}

constexpr int I_WIN = 16 * 96, I_WOUT = 16 * 32, I_WGU = 32 * 16 * 64, I_WD = 32 * 16 * 32, I_ALL = I_WIN + I_WOUT + I_WGU + I_WD;
struct CvItem { const float* src; unsigned char* dst; int ld; int kind; };
__device__ __forceinline__ CvItem cv_decode(int it, const float* w_in, const float* w_out, const float* wgu, const float* wd, bf16* winT, bf16* woutT, unsigned char* wguT, unsigned char* wdT) {
    CvItem d; int r = it;
    if (r < I_WIN) { const int kb = r / 96, nb = r % 96, k0 = 64 * kb; const int scol = nb < 64 ? 32 * nb : 2056 + 32 * (nb - 64);
        d.src = w_in + (size_t)k0 * IN_COLS + scol; d.ld = IN_COLS; d.dst = (unsigned char*)(winT + (size_t)(32 * nb) * 1024 + k0); d.kind = 0; return d; }
    r -= I_WIN;
    if (r < I_WOUT) { const int kb = r / 32, nb = r % 32, k0 = 64 * kb; d.src = w_out + (size_t)k0 * D + 32 * nb; d.ld = D; d.dst = (unsigned char*)(woutT + (size_t)(32 * nb) * 1024 + k0); d.kind = 0; return d; }
    r -= I_WOUT;
    if (r < I_WGU) { const int e = r / 1024, q = r % 1024, kb = q / 64, nb = q % 64, k0 = 64 * kb, n0 = 32 * nb;
        const int half = n0 / 1024, cc = n0 % 1024, pn = cc / 128, j0 = cc % 128, drow = e * 2048 + pn * 256 + half * 128 + j0;
        d.src = wgu + (size_t)e * 1024 * 2048 + (size_t)k0 * 2048 + n0; d.ld = 2048; d.dst = wguT + (size_t)drow * 1024 + k0; d.kind = 1; return d; }
    r -= I_WGU;
    { const int e = r / 512, q = r % 512, kb = q / 32, nb = q % 32, k0 = 64 * kb, n0 = 32 * nb;
      d.src = wd + (size_t)e * 1024 * 1024 + (size_t)k0 * 1024 + n0; d.ld = 1024; d.dst = wdT + (size_t)(e * 1024 + n0) * 1024 + k0; d.kind = 1; return d; }
}
__device__ __forceinline__ void cv_load(const CvItem& d, float (&r)[32], int lane) {
#pragma unroll
    for (int i = 0; i < 32; ++i) r[i] = d.src[(size_t)(2 * i + (lane >> 5)) * d.ld + (lane & 31)];
}
__device__ __forceinline__ void cv_store(const CvItem& d, const float (&r)[32], LAS float* scr, int lane) {
#pragma unroll
    for (int i = 0; i < 32; ++i) scr[(2 * i + (lane >> 5)) * 33 + (lane & 31)] = r[i];
    LDS_WAIT(); asm volatile("" ::: "memory");
    const int c = lane & 7;
    if (d.kind == 0) {
#pragma unroll
        for (int j = 0; j < 4; ++j) { const int n = (lane >> 3) + 8 * j; const LAS float* s = scr + (8 * c) * 33 + n;
            v4u o; o.x = pk2(s[0 * 33], s[1 * 33]); o.y = pk2(s[2 * 33], s[3 * 33]); o.z = pk2(s[4 * 33], s[5 * 33]); o.w = pk2(s[6 * 33], s[7 * 33]);
            *(v4u*)(d.dst + ((size_t)n * 1024 + 8 * c) * 2) = o; }
    } else {
#pragma unroll
        for (int j = 0; j < 4; ++j) { const int n = (lane >> 3) + 8 * j; const LAS float* s = scr + (8 * c) * 33 + n;
            int w0 = 0, w1 = 0;
            w0 = __builtin_amdgcn_cvt_pk_fp8_f32(32.f * s[0 * 33], 32.f * s[1 * 33], w0, false); w0 = __builtin_amdgcn_cvt_pk_fp8_f32(32.f * s[2 * 33], 32.f * s[3 * 33], w0, true);
            w1 = __builtin_amdgcn_cvt_pk_fp8_f32(32.f * s[4 * 33], 32.f * s[5 * 33], w1, false); w1 = __builtin_amdgcn_cvt_pk_fp8_f32(32.f * s[6 * 33], 32.f * s[7 * 33], w1, true);
            *(u32x2*)(d.dst + (size_t)n * 1024 + 8 * c) = (u32x2){(unsigned)w0, (unsigned)w1}; }
    }
    LDS_WAIT(); asm volatile("" ::: "memory");
}
__device__ __forceinline__ void cv_run(int it0, int it_end, int step, const float* w_in, const float* w_out, const float* wgu, const float* wd, bf16* winT, bf16* woutT, unsigned char* wguT, unsigned char* wdT, LAS float* scr, int lane) {
    for (int it = it0; it < it_end; it += step) {
        const CvItem cur = cv_decode(it, w_in, w_out, wgu, wd, winT, woutT, wguT, wdT);
        float r[32]; cv_load(cur, r, lane);
        cv_store(cur, r, scr, lane);
    }
}

constexpr int NWAVES = 8;
constexpr int RING_OFF = 0, RING_BYTES = 131072;
constexpr int LDSCTL_OFF = 144384, MISC_OFF = LDSCTL_OFF + 320;
static_assert(GP_END <= LDSCTL_OFF, "LDS map");
constexpr int LDS_BYTES = 147456;
constexpr int NGOUT = 48;
constexpr int CW_PROG = 65536;
constexpr int CW_BAR = 4096;
enum Phase { PH_PRO = 0, PH_PROJ = 1, PH_CONF = 2, PH_GPREP = 3, PH_GCHAIN = 4, PH_GOUT = 5, PH_OUT = 6, PH_RMS2 = 7, PH_ROUTE = 8, PH_MOE1 = 9, PH_MOE2 = 10, PH_COMB = 11 };
struct Args { const float* in[20]; float* out; unsigned char* ws; unsigned mask; int li; };

__global__ void __launch_bounds__(NWAVES * 64, 2) mega(Args args) {
    extern __shared__ __attribute__((aligned(16))) unsigned char lds[];
    LAS unsigned char* L = (LAS unsigned char*)lds;
    volatile LAS unsigned* MISC = (volatile LAS unsigned*)(L + MISC_OFF);
    const int tid = threadIdx.x, lane = tid & 63, wave = __builtin_amdgcn_readfirstlane(tid >> 6);
    const int G = gridDim.x, bx = blockIdx.x;
    const int vcu = (G % 8 == 0) ? (bx % 8) * (G / 8) + bx / 8 : bx;
#define ws (args.ws)
#define x_in (args.in[0])
#define attn_nw (args.in[1])
#define w_in (args.in[2])
#define gdn_cw (args.in[3])
#define a_log (args.in[4])
#define dt_bias (args.in[5])
#define gdn_nw (args.in[6])
#define cf_dw (args.in[7])
#define cf_db (args.in[8])
#define cf_lw (args.in[9])
#define cf_lb (args.in[10])
#define w_out (args.in[11])
#define ffn_nw (args.in[12])
#define w_router (args.in[13])
#define b_router (args.in[14])
#define wgu (args.in[15])
#define bgu (args.in[16])
#define wd (args.in[17])
#define bd (args.in[18])
#define final_nw (args.in[19])
#define hn ((bf16*)(ws + WS_HN))
#define xn8 ((unsigned char*)(ws + WS_HN))
#define proj ((bf16*)(ws + WS_PROJ))
#define beta ((float*)(ws + WS_BETA))
#define gl ((float*)(ws + WS_G))
#define mix ((bf16*)(ws + WS_MIX))
#define xmid ((bf16*)(ws + WS_XMID))
#define tope ((int*)(ws + WS_TOPE))
#define topg ((float*)(ws + WS_TOPG))
#define pos ((int*)(ws + WS_POS))
#define rowtok ((int*)(ws + WS_POS + 524288))
#define ghist ((int*)(ws + WS_HIST))
#define blke ((int*)(ws + WS_BLKE))
#define rgate ((float*)(ws + WS_RGATE))
#define wrh ((v4u*)(ws + WS_BLKE + 65536))
#define wrl ((v4u*)(ws + WS_BLKE + 131072))
#define xg ((unsigned char*)(ws + WS_XG))
#define hb ((unsigned char*)(ws + WS_HB))
#define yb ((unsigned char*)(ws + WS_Y))
#define winT ((bf16*)(ws + WS_WINT))
#define woutT ((bf16*)(ws + WS_WOUTT))
#define wguT ((unsigned char*)(ws + WS_WGUT))
#define wdT ((unsigned char*)(ws + WS_WDT))
#define Pf ((v4u*)(ws + WS_XG))
#define Qc ((v4u*)(ws + WS_XG + 32 * MiB))
#define RTf ((v4u*)(ws + WS_XG + 64 * MiB))
#define O0c ((u32x2*)(ws + WS_XG + 80 * MiB))
#define Sf ((v4u*)(ws + WS_XG + 112 * MiB))
#define out (args.out)

    for (int u = tid; u < (LDS_BYTES - LDSCTL_OFF) / 4; u += NWAVES * 64) ((LAS unsigned*)(L + LDSCTL_OFF))[u] = 0u;
    __syncthreads();
    const unsigned mask = args.mask;
    const bool multi = ((mask & 0xFFFu) & ((mask & 0xFFFu) - 1u)) != 0u;
    XcdBarrier bar; bar.bar = (unsigned*)(ws + WS_CTL) + CW_BAR + args.li * XCD_BAR_WORDS; bar.x = 0; bar.st = nullptr;
    if (multi) bar = xcd_barrier_post((unsigned*)(ws + WS_CTL) + CW_BAR + args.li * XCD_BAR_WORDS, MISC + 8);
#define IN(k) ((mask >> (k)) & 1u)
#define SEAM(k) do { if ((mask & 0xFFFu) >> ((k) + 1)) xcd_barrier(bar); } while (0)

    if (IN(PH_PRO)) {
        LAS float* scr = (LAS float*)(L + RING_OFF + wave * 16384);
        const int gw = vcu * NWAVES + wave, NGW = G * NWAVES;
        cv_run(gw, I_WIN, NGW, w_in, w_out, wgu, wd, winT, woutT, wguT, wdT, scr, lane);
        { const int gt = gw * 64 + lane;
          if (gt < 4096) { const int ks = gt >> 7, nt = (gt >> 6) & 1, r = gt & 15, q = (gt >> 4) & 3; unsigned hi[8], lo[8];
#pragma unroll
              for (int j = 0; j < 8; ++j) { const int k = 32 * ks + 8 * q + j; const float w = ffn_nw[k] * w_router[k * NE + 16 * nt + r]; hi[j] = f2bf(w); lo[j] = f2bf(w - bf2f(hi[j])); }
              v4u oh, ol; oh.x = hi[0] | (hi[1] << 16); oh.y = hi[2] | (hi[3] << 16); oh.z = hi[4] | (hi[5] << 16); oh.w = hi[6] | (hi[7] << 16);
              ol.x = lo[0] | (lo[1] << 16); ol.y = lo[2] | (lo[3] << 16); ol.z = lo[4] | (lo[5] << 16); ol.w = lo[6] | (lo[7] << 16);
              wrh[gt] = oh; wrl[gt] = ol; } }
        for (int t = gw * 4; t < T; t += NGW * 4) rms1_tokens<4>(t, lane, x_in, attn_nw, w_in, a_log, dt_bias, hn, beta, gl);
        SEAM(PH_PRO);
    }
    if (IN(PH_PROJ)) {
        pg8::Gemm g{hn, winT, T, PC, D}; pg8::StaticOrder S; S.init(T, PC, G, bx);
        pg8::EpiPlainBf16 E{proj, PC};
        pg8::gemm_phase<pg8::EpiPlainBf16, pg8::StaticOrder, true, true>(L + RING_OFF, g, S, E);
        SEAM(PH_PROJ);
    }
    if (IN(PH_CONF)) {
        for (int tile = bx; tile < T / 64; tile += G) conf_tile(tile, proj, cf_dw, cf_db, cf_lw, cf_lb, mix, (float*)(lds + RING_OFF));
        if (!IN(PH_GPREP)) SEAM(PH_CONF);
    }
    if (IN(PH_GPREP)) {
        for (int task = bx; task < 1024; task += G) gdn_prep_task(task, L, proj, gdn_cw, beta, gl, Pf, Qc, RTf, O0c);
        SEAM(PH_GPREP);
    }
    if (IN(PH_GCHAIN)) {
        if (bx < 64) {
            if (tid < 16) ((volatile LAS int*)(L + CH_FLAGS))[tid] = 0;
            __syncthreads();
            { if (wave == 0) gdn_chain_consumer(bx & 7, bx >> 3, lane, L, Sf, (unsigned*)(ws + WS_CTL) + CW_PROG + ((bx & 7) * 8 + (bx >> 3)) * 64); else if (wave < 7) gdn_chain_loader(wave - 1, bx & 7, bx >> 3, lane, L, Pf, Qc); }
        }
        else if (bx < 64 + NGOUT) {
            for (int p = bx - 64; p < 512; p += NGOUT) {
                const int n = p >> 2, bh0 = 2 * (p & 3);
                if (wave == 0) {
                    const unsigned* pw = (const unsigned*)(ws + WS_CTL) + CW_PROG + ((bh0 + ((lane >> 3) & 1)) * 8 + (lane & 7)) * 64;
                    unsigned sp = 0;
                    for (;;) { const unsigned v = __hip_atomic_load(pw, __ATOMIC_RELAXED, __HIP_MEMORY_SCOPE_AGENT); if (__all((lane >= 16) || (v >= (unsigned)(n + 1)))) break; __builtin_amdgcn_s_sleep(32); if (++sp > (1u << 20)) break; }
                    __builtin_amdgcn_fence(__ATOMIC_ACQUIRE, "agent");
                    asm volatile("s_waitcnt vmcnt(0)" ::: "memory");
                }
                __syncthreads();
                gdn_out_wave((bh0 + (wave >> 2)) * 128 + n, wave & 3, lane, Sf, RTf, O0c, proj, gdn_nw, mix);
                __syncthreads();
            }
        }
        else {
            {
                LAS float* scr = (LAS float*)(L + RING_OFF + wave * 16384);
                const int gw = (bx - 64 - NGOUT) * NWAVES + wave, NGW = (G - 64 - NGOUT) * NWAVES;
                cv_run(I_WIN + gw, I_ALL, NGW, w_in, w_out, wgu, wd, winT, woutT, wguT, wdT, scr, lane);
            }
        }
        SEAM(PH_GCHAIN);
    }
    if (IN(PH_OUT)) {
        pg8::Gemm g{mix, woutT, T, D, D}; pg8::StaticOrder S; S.init(T, D, G, bx);
        pg8::EpiResBf16 E{xmid, x_in, D};
        pg8::gemm_phase<pg8::EpiResBf16, pg8::StaticOrder, true, true>(L + RING_OFF, g, S, E);
        SEAM(PH_OUT);
    }
    if (IN(PH_RMS2)) {
        if (bx == 0 && tid < 64) ((v4u*)(xn8 + (size_t)T * D))[tid] = (v4u){0u, 0u, 0u, 0u};
        for (int grp = bx; grp < NWG; grp += G) rms2_group(grp, xmid, ffn_nw, wrh, wrl, b_router, xn8, tope, topg, ghist, lds + RING_OFF);
        SEAM(PH_RMS2);
    }
    if (IN(PH_ROUTE)) {
        for (int grp = bx; grp < NWG; grp += G) route_group(grp, ghist, tope, topg, rowtok, pos, rgate, blke, (int*)(lds + RING_OFF));
        SEAM(PH_ROUTE);
    }
    if (IN(PH_MOE1)) {
        pg8::Gemm g{(const pg8::bf16_t*)xn8, (const pg8::bf16_t*)wguT, RPAD, 2048, D / 2, rowtok}; pg8::MoeOrder S; S.init(blke, MAXBLK, 8, G, bx);
        pg8::EpiSwiglu E{hb, bgu};
        pg8::gemm_phase<pg8::EpiSwiglu, pg8::MoeOrder, true, true, 122, 127, true>(L + RING_OFF, g, S, E);
        SEAM(PH_MOE1);
    }
    if (IN(PH_MOE2)) {
        pg8::Gemm g{(const pg8::bf16_t*)hb, (const pg8::bf16_t*)wdT, RPAD, D, FF / 2}; pg8::MoeOrder S; S.init(blke, MAXBLK, 4, G, bx);
        pg8::EpiDown E{yb, bd, rgate};
        pg8::gemm_phase<pg8::EpiDown, pg8::MoeOrder, true, true, 122, 125>(L + RING_OFF, g, S, E);
        SEAM(PH_MOE2);
    }
    if (IN(PH_COMB)) {
        const int gw = vcu * NWAVES + wave, NGW = G * NWAVES;
        for (int t = gw; t < T; t += NGW) combine_token(t, lane, xmid, yb, pos, final_nw, out);
    }
#undef IN
#undef SEAM
#undef ws
#undef x_in
#undef attn_nw
#undef w_in
#undef gdn_cw
#undef a_log
#undef dt_bias
#undef gdn_nw
#undef cf_dw
#undef cf_db
#undef cf_lw
#undef cf_lb
#undef w_out
#undef ffn_nw
#undef w_router
#undef b_router
#undef wgu
#undef bgu
#undef wd
#undef bd
#undef final_nw
#undef hn
#undef proj
#undef beta
#undef gl
#undef mix
#undef xmid
#undef tope
#undef topg
#undef pos
#undef rowtok
#undef ghist
#undef blke
#undef rgate
#undef wrh
#undef wrl
#undef xg
#undef hb
#undef yb
#undef winT
#undef woutT
#undef wguT
#undef wdT
#undef Pf
#undef Qc
#undef RTf
#undef O0c
#undef Sf
#undef out
}

extern "C" void kernel_launch(void* const* d_in, const int* in_sizes, int n_in, void* d_out, int out_size, void* d_ws, size_t ws_size, hipStream_t stream) {
    static int grid = 0;
    if (grid == 0) {
        if (n_in != 20 || ws_size < WS_END) { fprintf(stderr, "kernel_launch: unexpected n_in %d / ws %zu (need %zu)\n", n_in, ws_size, (size_t)WS_END); grid = -1; return; }
        int dev = 0, cus = 0, per_cu = 0;
        if (hipGetDevice(&dev) != hipSuccess || hipDeviceGetAttribute(&cus, hipDeviceAttributeMultiprocessorCount, dev) != hipSuccess) { grid = -1; return; }
        if (hipFuncSetAttribute((const void*)mega, hipFuncAttributeMaxDynamicSharedMemorySize, LDS_BYTES) != hipSuccess) { fprintf(stderr, "kernel_launch: hipFuncSetAttribute failed\n"); grid = -1; return; }
        if (hipOccupancyMaxActiveBlocksPerMultiprocessor(&per_cu, (const void*)mega, NWAVES * 64, LDS_BYTES) != hipSuccess || per_cu < 1) { fprintf(stderr, "kernel_launch: occupancy query says %d\n", per_cu); }
        (void)hipGetLastError();
        grid = cus;
    }
    if (grid < 0) return;
    unsigned char* ws = (unsigned char*)d_ws;
    if (hipMemsetAsync(ws + WS_CTL, 0, 1 * MiB, stream) != hipSuccess) return;
    Args a{};
    for (int i = 0; i < 20; ++i) a.in[i] = (const float*)d_in[i];
    a.out = (float*)d_out; a.ws = ws;
    a.mask = 0xFFFu & ~(1u << PH_GOUT); a.li = 0;
    hipLaunchKernelGGL(mega, dim3(grid), dim3(NWAVES * 64), LDS_BYTES, stream, a);
}
```
